# Optimizing an MI355X kernel written in HIP

```python
import math
import jax, jax.numpy as jnp
from jax import lax
import numpy as np

D_MODEL = 2048
BATCH = 32
SEQ = 256
DEPTH = 2
DEC_BATCH = 2
DEC_SEQ = 2048
PAST_LEN = 256

GRID_W = 64
GLA_HEADS = 4
GLA_DK = D_MODEL // 2 // GLA_HEADS
GLA_DV = D_MODEL // GLA_HEADS
GLA_RANK = 16
GLA_TAU = 16.0
GLA_CHUNK = 64
DIFF_DH = 128
DIFF_HEADS = D_MODEL // (2 * DIFF_DH)
ROPE_AXIS_DIM = DIFF_DH // 2
ROPE_BASE = 10000.0
ATTN_BLOCK = 128
FNET_WIDTH = D_MODEL
FNET_GROUPS = 4
FNET_GC = FNET_WIDTH // FNET_GROUPS
D_FF = ((8 * D_MODEL) // 3 + 255) // 256 * 256
RMS_EPS = 1e-6
GLA_QK_W = GLA_HEADS * GLA_DK
GLA_V_W = GLA_HEADS * GLA_DV
DIFF_W = DIFF_HEADS * 2 * DIFF_DH
IN_SIZES = (GLA_QK_W, GLA_QK_W, GLA_V_W, GLA_RANK, GLA_RANK, GLA_V_W,
            DIFF_W, DIFF_W, DIFF_W, FNET_WIDTH, 3 * D_MODEL)
N_IN = sum(IN_SIZES)

kernel_name = 'hybrid_gla_fnet_diffattn_prefix_denoise_step'


def rmsnorm(x, g):
    xf = x.astype(jnp.float32)
    y = xf * lax.rsqrt(jnp.mean(xf * xf, axis=-1, keepdims=True) + RMS_EPS)
    return (y * g.astype(jnp.float32)).astype(x.dtype)


def split_in(z):
    offs = np.cumsum(IN_SIZES)[:-1].tolist()
    return jnp.split(z, offs, axis=-1)


def gla_direction(q, k, v, log_a, s0):
    B, L, H, _ = q.shape
    n = L // GLA_CHUNK

    def chunks(t):
        t = t.astype(jnp.float32)
        return t.reshape(B, n, GLA_CHUNK, H, t.shape[-1]).transpose(1, 0, 3, 2, 4)

    qc, kc, vc, ac = chunks(q), chunks(k), chunks(v), chunks(log_a)
    b = jnp.cumsum(ac, axis=-2)
    b_last = b[..., -1:, :]
    q_in = qc * jnp.exp(b)
    k_in = kc * jnp.exp(-b)
    k_end = kc * jnp.exp(b_last - b)
    lower = jnp.tril(jnp.ones((GLA_CHUNK, GLA_CHUNK), dtype=bool))
    a = jnp.where(lower, jnp.einsum('nbhtd,nbhsd->nbhts', q_in, k_in), 0.0)
    o_intra = jnp.einsum('nbhts,nbhsv->nbhtv', a, vc)

    def step(S, xs):
        q_i, k_i, v_i, bl_i = xs
        o_i = jnp.einsum('bhtd,bhdv->bhtv', q_i, S)
        S = S * jnp.exp(bl_i)[:, :, 0, :, None] + jnp.einsum('bhsd,bhsv->bhdv', k_i, v_i)
        return S, o_i

    s_fin, o_inter = lax.scan(step, s0.astype(jnp.float32), (q_in, k_end, vc, b_last))
    o = (o_intra + o_inter).transpose(1, 0, 3, 2, 4).reshape(B, L, H, -1)
    return o, s_fin


def gla_mixer(zq, zk, zv, zaf, zab, zg, lp, s0_f, s0_b):
    B, L, _ = zq.shape
    q = zq.reshape(B, L, GLA_HEADS, GLA_DK) * (GLA_DK ** -0.5)
    k = zk.reshape(B, L, GLA_HEADS, GLA_DK)
    v = zv.reshape(B, L, GLA_HEADS, GLA_DV)

    def log_decay(z, w2, b2):
        za = (z @ w2 + b2).astype(jnp.float32)
        return (jax.nn.log_sigmoid(za) / GLA_TAU).reshape(B, L, GLA_HEADS, GLA_DK)

    la_f = log_decay(zaf, lp['w_gla_a2_f'], lp['b_gla_a_f'])
    la_b = log_decay(zab, lp['w_gla_a2_b'], lp['b_gla_a_b'])
    o_f, s_f = gla_direction(q, k, v, la_f, s0_f)
    flip = lambda t: jnp.flip(t, axis=1)
    o_b, s_b = gla_direction(flip(q), flip(k), flip(v), flip(la_b), s0_b)
    o = (o_f + flip(o_b)).astype(zq.dtype)
    o = rmsnorm(o, lp['g_gla']) * jax.nn.silu(zg.reshape(B, L, GLA_HEADS, GLA_DV))
    return o.reshape(B, L, GLA_V_W), s_f, s_b


def fourier_mix(u):
    B, L, _ = u.shape
    ug = u.astype(jnp.float32).reshape(B, L, FNET_GROUPS, FNET_GC)
    f = jnp.fft.fft2(ug, axes=(1, 3), norm='ortho').real
    return f.reshape(B, L, FNET_WIDTH).astype(u.dtype)


def axial_rope(x):
    L = x.shape[1]
    n_rows = L // GRID_W
    rows = jnp.repeat(jnp.arange(n_rows, dtype=jnp.float32), GRID_W)
    cols = jnp.tile(jnp.arange(GRID_W, dtype=jnp.float32), n_rows)
    nf = ROPE_AXIS_DIM // 2
    inv = ROPE_BASE ** (-jnp.arange(nf, dtype=jnp.float32) / nf)

    def rot(xh, pos):
        ang = pos[:, None] * inv
        cos = jnp.cos(ang)[None, :, None, None, :]
        sin = jnp.sin(ang)[None, :, None, None, :]
        x1, x2 = xh[..., :nf], xh[..., nf:]
        return jnp.concatenate([x1 * cos - x2 * sin, x2 * cos + x1 * sin], axis=-1)

    xf = x.astype(jnp.float32)
    out = jnp.concatenate([rot(xf[..., :ROPE_AXIS_DIM], rows), rot(xf[..., ROPE_AXIS_DIM:], cols)], axis=-1)
    return out.astype(x.dtype)


def diff_attention_mixer(q, k, v, lp, layer_idx):
    B, Lq = q.shape[:2]
    nb = Lq // ATTN_BLOCK
    lam_init = 0.8 - 0.6 * math.exp(-0.3 * layer_idx)
    f32 = jnp.float32
    lam = (jnp.exp(jnp.sum(lp['lam_q1'].astype(f32) * lp['lam_k1'].astype(f32)))
           - jnp.exp(jnp.sum(lp['lam_q2'].astype(f32) * lp['lam_k2'].astype(f32))) + lam_init)
    qb = q.reshape(B, nb, ATTN_BLOCK, DIFF_HEADS, 2, DIFF_DH).transpose(1, 0, 2, 3, 4, 5)
    kf = k.astype(f32)
    vf = v.astype(f32)
    scale = DIFF_DH ** -0.5

    def block(qi):
        s = jnp.einsum('bqhcd,bkhcd->bchqk', qi.astype(f32), kf) * scale
        p = jax.nn.softmax(s, axis=-1)
        w = p[:, 0] - lam * p[:, 1]
        return jnp.einsum('bhqk,bkhv->bqhv', w, vf)

    o = lax.map(block, qb)
    o = o.transpose(1, 0, 2, 3, 4).reshape(B, Lq, DIFF_HEADS, 2 * DIFF_DH).astype(q.dtype)
    o = rmsnorm(o, lp['g_diff']) * (1.0 - lam_init)
    return o.reshape(B, Lq, DIFF_W)


def conv_ffn(h, lp):
    u = h @ lp['w_up']
    val, gate = jnp.split(u, 2, axis=-1)
    gp = jnp.pad(gate, ((0, 0), (1, 1), (0, 0)))
    w = lp['conv_w']
    gate = gp[:, :-2] * w[0] + gp[:, 1:-1] * w[1] + gp[:, 2:] * w[2] + lp['conv_b']
    return (jax.nn.gelu(gate) * val) @ lp['w_down']


def trunk_layer(x, cond, lp, layer_idx, ctx):
    B, L, _ = x.shape
    mod = jax.nn.silu(cond) @ lp['w_mod'] + lp['b_mod']
    sh1, sc1, gt1, sh2, sc2, gt2 = [m[:, None, :] for m in jnp.split(mod, 6, axis=-1)]
    h = rmsnorm(x, lp['g_pre1']) * (1.0 + sc1) + sh1
    zq, zk, zv, zaf, zab, zg, dq, dk, dv, zf, zgate = split_in(h @ lp['w_in'])
    if ctx is None:
        s0 = jnp.zeros((B, GLA_HEADS, GLA_DK, GLA_DV), jnp.float32)
        s0_f, s0_b = s0, s0
    else:
        k_ctx, v_ctx, s0_f, s0_b = ctx
    o_gla, s_f, s_b = gla_mixer(zq, zk, zv, zaf, zab, zg, lp, s0_f, s0_b)
    o_fnet = fourier_mix(zf)
    q = dq.reshape(B, L, DIFF_HEADS, 2, DIFF_DH)
    k = dk.reshape(B, L, DIFF_HEADS, 2, DIFF_DH)
    v = dv.reshape(B, L, DIFF_HEADS, 2 * DIFF_DH)
    if ctx is None:
        k_all, v_all = k, v
    else:
        q = axial_rope(q)
        k_c = k_ctx.reshape(B, k_ctx.shape[1], DIFF_HEADS, 2, DIFF_DH).astype(k.dtype)
        k_all = jnp.concatenate([k_c, axial_rope(k)], axis=1)
        v_all = jnp.concatenate([v_ctx.astype(v.dtype), v], axis=1)
    o_diff = diff_attention_mixer(q, k_all, v_all, lp, layer_idx)
    g_a, g_b, g_c = jnp.split(jax.nn.sigmoid(zgate), 3, axis=-1)
    merged = (g_a * (o_gla @ lp['w_br_gla']) + g_b * (o_fnet @ lp['w_br_fnet'])
              + g_c * (o_diff @ lp['w_br_diff']))
    x = x + gt1 * rmsnorm(merged @ lp['w_out'], lp['g_post1'])
    h2 = rmsnorm(x, lp['g_pre2']) * (1.0 + sc2) + sh2
    x = x + gt2 * rmsnorm(conv_ffn(h2, lp), lp['g_post2'])
    if ctx is None:
        ctx_out = (dk.reshape(B, L, DIFF_HEADS, 2 * DIFF_DH), v,
                   s_f.astype(x.dtype), s_b.astype(x.dtype))
        return x, ctx_out
    return x, None


def setup_inputs(seed: int = 0) -> dict:
    key = jax.random.key(seed)
    keys = iter(jax.random.split(key, 40))
    D = D_MODEL

    def nrm(shape, scale):
        return jax.random.normal(next(keys), shape, jnp.float32) * scale

    def gain(shape):
        return 1.0 + nrm(shape, 0.05)

    return {
        'x_prompt': nrm((BATCH, SEQ, D), 1.0),
        'x_sample': nrm((DEC_BATCH, DEC_SEQ, D), 1.0),
        'cache_k': nrm((DEC_BATCH, DEPTH, PAST_LEN, DIFF_HEADS, 2 * DIFF_DH), 1.0),
        'cache_v': nrm((DEC_BATCH, DEPTH, PAST_LEN, DIFF_HEADS, 2 * DIFF_DH), 1.0),
        'state_gla_fwd': nrm((DEC_BATCH, DEPTH, GLA_HEADS, GLA_DK, GLA_DV), 1.0),
        'state_gla_bwd': nrm((DEC_BATCH, DEPTH, GLA_HEADS, GLA_DK, GLA_DV), 1.0),
        'c': nrm((DEC_BATCH, D), 1.0),
        'c_ctx': nrm((D,), 1.0),
        'w_mod': nrm((DEPTH, D, 6 * D), D ** -0.5),
        'b_mod': nrm((DEPTH, 6 * D), 0.01),
        'g_pre1': gain((DEPTH, D)),
        'g_post1': gain((DEPTH, D)),
        'g_pre2': gain((DEPTH, D)),
        'g_post2': gain((DEPTH, D)),
        'w_in': nrm((DEPTH, D, N_IN), D ** -0.5),
        'w_gla_a2_f': nrm((DEPTH, GLA_RANK, GLA_QK_W), GLA_RANK ** -0.5),
        'b_gla_a_f': nrm((DEPTH, GLA_QK_W), 0.1),
        'w_gla_a2_b': nrm((DEPTH, GLA_RANK, GLA_QK_W), GLA_RANK ** -0.5),
        'b_gla_a_b': nrm((DEPTH, GLA_QK_W), 0.1),
        'g_gla': gain((DEPTH, GLA_DV)),
        'lam_q1': nrm((DEPTH, DIFF_DH), 0.1),
        'lam_k1': nrm((DEPTH, DIFF_DH), 0.1),
        'lam_q2': nrm((DEPTH, DIFF_DH), 0.1),
        'lam_k2': nrm((DEPTH, DIFF_DH), 0.1),
        'g_diff': gain((DEPTH, 2 * DIFF_DH)),
        'w_br_gla': nrm((DEPTH, GLA_V_W, D), GLA_V_W ** -0.5),
        'w_br_fnet': nrm((DEPTH, FNET_WIDTH, D), FNET_WIDTH ** -0.5),
        'w_br_diff': nrm((DEPTH, DIFF_W, D), DIFF_W ** -0.5),
        'w_out': nrm((DEPTH, D, D), D ** -0.5),
        'w_up': nrm((DEPTH, D, 2 * D_FF), D ** -0.5),
        'conv_w': nrm((DEPTH, 3, D_FF), 3 ** -0.5),
        'conv_b': nrm((DEPTH, D_FF), 0.01),
        'w_down': nrm((DEPTH, D_FF, D), D_FF ** -0.5),
    }


def reference(x_prompt, x_sample, cache_k, cache_v, state_gla_fwd, state_gla_bwd, c, c_ctx,
              w_mod, b_mod, g_pre1, g_post1, g_pre2, g_post2, w_in,
              w_gla_a2_f, b_gla_a_f, w_gla_a2_b, b_gla_a_b, g_gla,
              lam_q1, lam_k1, lam_q2, lam_k2, g_diff,
              w_br_gla, w_br_fnet, w_br_diff, w_out,
              w_up, conv_w, conv_b, w_down):
    def layer_params(l):
        return {'w_mod': w_mod[l], 'b_mod': b_mod[l], 'g_pre1': g_pre1[l], 'g_post1': g_post1[l],
                'g_pre2': g_pre2[l], 'g_post2': g_post2[l], 'w_in': w_in[l],
                'w_gla_a2_f': w_gla_a2_f[l], 'b_gla_a_f': b_gla_a_f[l],
                'w_gla_a2_b': w_gla_a2_b[l], 'b_gla_a_b': b_gla_a_b[l], 'g_gla': g_gla[l],
                'lam_q1': lam_q1[l], 'lam_k1': lam_k1[l], 'lam_q2': lam_q2[l], 'lam_k2': lam_k2[l],
                'g_diff': g_diff[l], 'w_br_gla': w_br_gla[l], 'w_br_fnet': w_br_fnet[l],
                'w_br_diff': w_br_diff[l], 'w_out': w_out[l], 'w_up': w_up[l],
                'conv_w': conv_w[l], 'conv_b': conv_b[l], 'w_down': w_down[l]}

    y_prompt = x_prompt
    ks, vs, sfs, sbs = [], [], [], []
    for l in range(DEPTH):
        y_prompt, (k_l, v_l, sf_l, sb_l) = trunk_layer(y_prompt, c_ctx[None, :], layer_params(l), l, None)
        ks.append(k_l)
        vs.append(v_l)
        sfs.append(sf_l)
        sbs.append(sb_l)
    new_k = jnp.stack(ks, axis=1)
    new_v = jnp.stack(vs, axis=1)
    new_state_fwd = jnp.stack(sfs, axis=1)
    new_state_bwd = jnp.stack(sbs, axis=1)

    y_sample = x_sample
    for l in range(DEPTH):
        ctx = (cache_k[:, l], cache_v[:, l], state_gla_fwd[:, l], state_gla_bwd[:, l])
        y_sample, _ = trunk_layer(y_sample, c, layer_params(l), l, ctx)

    return (y_prompt, y_sample, new_k, new_v, new_state_fwd, new_state_bwd)
```

```cpp
#include <hip/hip_runtime.h>
#include <cstdio>
#include <cstdint>

#ifndef MK_MODE
#define MK_MODE 0
#endif
#ifndef MK_DBG
#define MK_DBG 0
#endif

#define LAS __attribute__((address_space(3)))
#define GAS __attribute__((address_space(1)))
typedef unsigned short bf16_t;
typedef short bf16x8 __attribute__((ext_vector_type(8)));
typedef short s16x4 __attribute__((ext_vector_type(4)));
typedef float f32x4 __attribute__((ext_vector_type(4)));
typedef float f32x2 __attribute__((ext_vector_type(2)));
typedef float f32x8 __attribute__((ext_vector_type(8)));
typedef float f32x16 __attribute__((ext_vector_type(16)));
typedef unsigned u32x4 __attribute__((ext_vector_type(4)));
typedef unsigned u32x2 __attribute__((ext_vector_type(2)));

constexpr int D = 2048, RC = 8192, RL = 4096, R = 12288, NBC = 32, LC = 256, NBL = 2, LL = 2048, PAST = 256;
constexpr int DFF = 5632, NUP = 11264, NMOD = 12288, NIN_SRC = 20512, NIN_MAIN = 18688, NIN_PAD = 20736;
constexpr int KROWS = RC + NBL * (PAST + LL);
constexpr float EPS = 1e-6f;
constexpr int NPH = 27;
constexpr size_t O_Y = 0, O_NK = 25165824, O_NV = 58720256, O_SF = 92274688, O_SB = 125829120, O_END = 159383552;
constexpr size_t MiB = 1u << 20;
constexpr size_t WS_CTL = 0, CTL_BYTES = 1 * MiB;
constexpr size_t WS_MOD = 1 * MiB, WS_DECAY = 2 * MiB, WS_ZA = 4 * MiB, WS_T512 = 6 * MiB, WS_T256 = 7 * MiB, WS_T2048 = 8 * MiB;
constexpr size_t WS_WIN = 24 * MiB, WS_WBR = 105 * MiB, WS_WOUT = 129 * MiB, WS_WUP = 137 * MiB, WS_WDOWN = 181 * MiB;
constexpr size_t WS_H = 203 * MiB, WS_ZQ = 251 * MiB, WS_ZK = 275 * MiB, WS_ZVT = 299 * MiB, WS_ZG = 347 * MiB, WS_DQ = 395 * MiB, WS_DK = 443 * MiB, WS_DV = 493 * MiB;
constexpr size_t WS_ZF = 543 * MiB, WS_GATE = 591 * MiB, WS_QIN = 735 * MiB, WS_KENDT = 783 * MiB, WS_Y = 831 * MiB, WS_OINTRA = 927 * MiB, WS_OPART = 975 * MiB;
constexpr size_t WS_OF = 1071 * MiB, WS_OB = 1119 * MiB, WS_OFNET = 1167 * MiB, WS_SG = 1215 * MiB, WS_SV = 1224 * MiB, WS_XB2 = 1230 * MiB  , WS_END = 1278 * MiB;
constexpr size_t WS_MERGED = WS_H, WS_AGLA = WS_ZQ, WS_ADIFF = WS_ZF, WS_P = WS_DQ  , WS_YOUT = WS_Y, WS_U = WS_OINTRA, WS_ACT = WS_GATE, WS_X1B = WS_OF  , WS_UPQ = WS_OPART  , WS_ZAP = WS_OPART  ;
constexpr int CW_BAR = 4096;
constexpr int CW_Q = 1024;
constexpr int CW_ERR = 2048;

__device__ __forceinline__ float bf2f(bf16_t b) { return __uint_as_float(((unsigned)b) << 16); }
typedef __bf16 bf16x2_t __attribute__((ext_vector_type(2)));
__device__ __forceinline__ unsigned pk2(float lo, float hi) { const f32x2 v = {lo, hi}; const bf16x2_t b = __builtin_convertvector(v, bf16x2_t); return __builtin_bit_cast(unsigned, b); }
__device__ __forceinline__ unsigned f2bf(float f) { return pk2(f, 0.f) & 0xffffu; }
__device__ __forceinline__ float lo16(unsigned w) { return __uint_as_float(w << 16); }
__device__ __forceinline__ float hi16(unsigned w) { return __uint_as_float(w & 0xffff0000u); }
__device__ __forceinline__ unsigned cvt_pk_bf16(float lo, float hi) { unsigned r; asm volatile("v_cvt_pk_bf16_f32 %0, %1, %2" : "=v"(r) : "v"(lo), "v"(hi)); return r; }
__device__ __forceinline__ float shx(float v, int mask, int lane) { return __int_as_float(__builtin_amdgcn_ds_bpermute((lane ^ mask) << 2, __float_as_int(v))); }
__device__ __forceinline__ float wave_sum(float v, int lane) {
#pragma unroll
    for (int o = 1; o < 64; o <<= 1) v += shx(v, o, lane);
    return v;
}
__device__ __forceinline__ int ltid(int wave) { unsigned z = 0u; asm volatile("" : "+s"(z));
    int t = (wave << 6) | (int)__builtin_amdgcn_mbcnt_hi(~0u, __builtin_amdgcn_mbcnt_lo(~0u, z)); asm volatile("" : "+v"(t)); return t; }
__device__ __forceinline__ float sigmoid_f(float x) { return __builtin_amdgcn_rcpf(1.0f + __builtin_amdgcn_exp2f(-1.4426950408889634f * x)); }
__device__ __forceinline__ float silu_f(float x) { return x * sigmoid_f(x); }
__device__ __forceinline__ float logsig_f(float x) { return fminf(x, 0.0f) - 0.6931471805599453f * __builtin_amdgcn_logf(1.0f + __builtin_amdgcn_exp2f(-1.4426950408889634f * fabsf(x))); }
__device__ __forceinline__ float gelu_tanh_f(float x) { const float u2 = 1.5957691216057308f * (x + 0.044715f * x * x * x); return x * sigmoid_f(u2); }
__device__ __forceinline__ void unpack8(const u32x4 w, float (&f)[8]) { f[0] = lo16(w.x); f[1] = hi16(w.x); f[2] = lo16(w.y); f[3] = hi16(w.y); f[4] = lo16(w.z); f[5] = hi16(w.z); f[6] = lo16(w.w); f[7] = hi16(w.w); }
__device__ __forceinline__ u32x4 pack8(const float (&f)[8]) { u32x4 w; w.x = pk2(f[0], f[1]); w.y = pk2(f[2], f[3]); w.z = pk2(f[4], f[5]); w.w = pk2(f[6], f[7]); return w; }

namespace pg8 {
#define PG8_LAS __attribute__((address_space(3)))
constexpr int BM = 256, BK = 64, HALF = 128, HTB = HALF * BK * 2, STAGE_BYTES = 8 * HTB, NXCD = 8, WGM = 4;
__device__ __forceinline__ int lds_byte(int r, int c) { const int st = (r >> 4) * 2 + (c >> 5), rr = r & 15, cc = c & 31, ob = rr * 64 + cc * 2; return st * 1024 + (ob ^ (((ob >> 9) & 1) << 5)); }
__device__ __forceinline__ void stage_rc(int b, int& Rr, int& C) { const int st = b / 1024, sb = b % 1024, swz = sb ^ (((sb >> 9) & 1) << 5); Rr = (st >> 1) * 16 + swz / 64; C = (st & 1) * 32 + (swz % 64) / 2; }
__device__ __forceinline__ int perm32(int rho) { const int n = rho >> 4, i = rho & 15; return 8 * (i >> 2) + 4 * n + (i & 3); }
struct Unit { const char* a; const char* b; int pm, pn, z, nt; };
struct Gemm { int lda, ldb, K; };
__device__ __forceinline__ void tile_order(int L, int nM, int nN, int& pm, int& pn) {
    const int nwg = nM * nN; int wgid = L;
    { const int q = nwg / NXCD, r = nwg % NXCD, xcd = wgid % NXCD, off = wgid / NXCD; wgid = (xcd < r ? xcd * (q + 1) : r * (q + 1) + (xcd - r) * q) + off; }
    const int nig = WGM * nN, gid = wgid / nig, fm = gid * WGM, gsz = (nM - fm) < WGM ? (nM - fm) : WGM;
    pm = fm + ((wgid % nig) % gsz); pn = (wgid % nig) / gsz;
}
typedef f32x4 Acc[2][2][4][2];

template <class Epi, class Sched, bool ALIGN_EPI = false, bool SP2 = false>
__device__ __forceinline__ void gemm_phase(PG8_LAS unsigned char* lds, const Gemm g, const Sched& S, const Epi& E, int wave0) {
    const int tid = ltid(wave0), wid = __builtin_amdgcn_readfirstlane(tid >> 6), lane = tid & 63, wr = wid >> 2, wc = wid & 3, fr = lane & 15, fq = lane >> 4;
    const int K = g.K, nt = K / BK;
    unsigned voffA[2], voffB[2];
#pragma unroll
    for (int i = 0; i < 2; ++i) { int Rr, C; stage_rc(tid * 16 + i * 8192, Rr, C); const int Rb = Epi::PERM ? ((Rr & ~31) + perm32(Rr & 31)) : Rr;
        voffA[i] = (unsigned)(Rr * g.lda + C) * 2u; voffB[i] = (unsigned)(Rb * g.ldb + C) * 2u; }
    const size_t kstep = (size_t)(BK * 2);
    const size_t hstepA = (size_t)HALF * g.lda * 2, hstepB = (size_t)HALF * g.ldb * 2;
    const unsigned ldsw = (unsigned)wid * 1024u;
    const int aoff = lds_byte(wr * 64 + fr, fq * 8), boff = lds_byte(wc * 32 + fr, fq * 8);
#define PG8_SA(b, h) (((b) * 2 + (h)) * HTB)
#define PG8_SB(b, h) ((4 + (b) * 2 + (h)) * HTB)
#define PG8_STAGE(bufoff, gbase, voff) do { _Pragma("unroll") for (int _i = 0; _i < 2; ++_i) \
        __builtin_amdgcn_global_load_lds((const unsigned*)((const char*)(gbase) + (voff)[_i]), (PG8_LAS unsigned*)(lds + (bufoff) + ldsw + _i * 8192), 16, 0, 0); } while (0)
#define PG8_LDA(dst, b, h) do { _Pragma("unroll") for (int m = 0; m < 4; ++m) _Pragma("unroll") for (int k = 0; k < 2; ++k) dst[m][k] = *(const PG8_LAS bf16x8*)(lds + PG8_SA(b, h) + aoff + m * 2048 + k * 1024); } while (0)
#define PG8_LDB(dst, b, h) do { _Pragma("unroll") for (int n = 0; n < 2; ++n) _Pragma("unroll") for (int k = 0; k < 2; ++k) dst[n][k] = *(const PG8_LAS bf16x8*)(lds + PG8_SB(b, h) + boff + n * 2048 + k * 1024); } while (0)
#define PG8_MMA(ai, bj, At, Bt) do { __builtin_amdgcn_s_setprio(1); _Pragma("unroll") for (int m = 0; m < 4; ++m) _Pragma("unroll") for (int n = 0; n < 2; ++n) _Pragma("unroll") for (int k = 0; k < 2; ++k) \
        acc[ai][bj][m][n] = __builtin_amdgcn_mfma_f32_16x16x32_bf16(Bt[n][k], At[m][k], acc[ai][bj][m][n], 0, 0, 0); __builtin_amdgcn_s_setprio(0); } while (0)
#define PG8_WAIT_V(n) asm volatile("s_waitcnt vmcnt(" #n ")" ::: "memory")
#define PG8_WAIT_L(n) asm volatile("s_waitcnt lgkmcnt(" #n ")" ::: "memory")
#define PG8_BAR __builtin_amdgcn_s_barrier()
#define PG8_SCHED __builtin_amdgcn_sched_barrier(0)
    Unit cur, nxt; int ui = 0;
    cur.nt = 0;
    if (!S.next(0, cur)) return;
    f32x4 acc[2][2][4][2];
#pragma unroll
    for (int a = 0; a < 2; ++a)
#pragma unroll
        for (int b = 0; b < 2; ++b)
#pragma unroll
            for (int m = 0; m < 4; ++m)
#pragma unroll
                for (int n = 0; n < 2; ++n) acc[a][b][m][n] = (f32x4){0.f, 0.f, 0.f, 0.f};
    bf16x8 At[4][2], B0[2][2], B1[2][2];
    const char* cA = cur.a; const char* cB = cur.b;
    if constexpr (SP2) {
        PG8_STAGE(PG8_SB(0, 0), cB, voffB); PG8_STAGE(PG8_SB(0, 1), cB + hstepB, voffB); PG8_STAGE(PG8_SA(0, 0), cA, voffA); PG8_STAGE(PG8_SA(0, 1), cA + hstepA, voffA);
        if (wr == 1) PG8_BAR;
        PG8_WAIT_V(2); PG8_BAR;
        PG8_STAGE(PG8_SB(1, 0), cB + kstep, voffB); PG8_STAGE(PG8_SA(1, 0), cA + kstep, voffA); PG8_STAGE(PG8_SB(1, 1), cB + hstepB + kstep, voffB);
        PG8_WAIT_V(6); PG8_BAR;
    } else {
        PG8_STAGE(PG8_SB(0, 0), cB, voffB); PG8_STAGE(PG8_SA(0, 0), cA, voffA); PG8_STAGE(PG8_SB(0, 1), cB + hstepB, voffB); PG8_STAGE(PG8_SA(0, 1), cA + hstepA, voffA);
        if (wr == 1) PG8_BAR;
        PG8_WAIT_V(4); PG8_BAR;
        PG8_STAGE(PG8_SB(1, 0), cB + kstep, voffB); PG8_STAGE(PG8_SA(1, 0), cA + kstep, voffA); PG8_STAGE(PG8_SB(1, 1), cB + hstepB + kstep, voffB);
        PG8_WAIT_V(6); PG8_BAR;
    }
    for (;;) {
        nxt.nt = 0; const bool has_next = S.next(ui + 1, nxt);
        const int ntc = cur.nt ? cur.nt : nt;
        const char* nA = has_next ? nxt.a : cA; const char* nB = has_next ? nxt.b : cB;
        for (int t = 0; t < ntc; t += 2) {
            const bool last = (t == ntc - 2);
            const char* a1 = cA + (size_t)(t + 1) * kstep;
            const char* a2 = last ? nA : cA + (size_t)(t + 2) * kstep; const char* b2 = last ? nB : cB + (size_t)(t + 2) * kstep;
            const char* a3 = a2 + kstep; const char* b3 = b2 + kstep;
            if constexpr (SP2) {
            PG8_LDB(B0, 0, 0); PG8_LDB(B1, 0, 1); PG8_SCHED; PG8_LDA(At, 0, 0); PG8_STAGE(PG8_SA(1, 1), a1 + hstepA, voffA);
            PG8_WAIT_V(8); PG8_WAIT_L(0); PG8_BAR; PG8_MMA(0, 0, At, B0); PG8_MMA(0, 1, At, B1); PG8_BAR; PG8_SCHED;
            PG8_LDA(At, 0, 1); PG8_STAGE(PG8_SB(0, 0), b2, voffB); PG8_STAGE(PG8_SB(0, 1), b2 + hstepB, voffB); PG8_STAGE(PG8_SA(0, 0), a2, voffA);
            PG8_WAIT_V(8); PG8_WAIT_L(0); PG8_BAR; PG8_MMA(1, 0, At, B0); PG8_MMA(1, 1, At, B1); PG8_BAR; PG8_SCHED;
            PG8_LDB(B0, 1, 0); PG8_LDB(B1, 1, 1); PG8_SCHED; PG8_LDA(At, 1, 0); PG8_STAGE(PG8_SA(0, 1), a2 + hstepA, voffA);
            PG8_WAIT_V(8); PG8_WAIT_L(0); PG8_BAR; PG8_MMA(0, 0, At, B0); PG8_MMA(0, 1, At, B1); PG8_BAR; PG8_SCHED;
            PG8_LDA(At, 1, 1); PG8_STAGE(PG8_SB(1, 0), b3, voffB); PG8_STAGE(PG8_SB(1, 1), b3 + hstepB, voffB); PG8_STAGE(PG8_SA(1, 0), a3, voffA);
            PG8_WAIT_V(8); PG8_WAIT_L(0); PG8_BAR; PG8_MMA(1, 0, At, B0); PG8_MMA(1, 1, At, B1); PG8_BAR; PG8_SCHED;
            } else {
            PG8_LDB(B0, 0, 0); PG8_SCHED; PG8_LDA(At, 0, 0); PG8_STAGE(PG8_SA(1, 1), a1 + hstepA, voffA);
            PG8_WAIT_L(8); PG8_BAR; PG8_WAIT_L(0); PG8_MMA(0, 0, At, B0); PG8_BAR; PG8_SCHED;
            PG8_LDB(B1, 0, 1); PG8_STAGE(PG8_SB(0, 0), b2, voffB);
            PG8_BAR; PG8_WAIT_L(0); PG8_MMA(0, 1, At, B1); PG8_BAR;
            PG8_LDA(At, 0, 1); PG8_STAGE(PG8_SA(0, 0), a2, voffA);
            PG8_BAR; PG8_WAIT_L(0); PG8_MMA(1, 0, At, B0); PG8_BAR; PG8_SCHED;
            PG8_STAGE(PG8_SB(0, 1), b2 + hstepB, voffB);
            PG8_WAIT_V(6); PG8_BAR; PG8_MMA(1, 1, At, B1); PG8_BAR;
            PG8_LDB(B0, 1, 0); PG8_SCHED; PG8_LDA(At, 1, 0); PG8_STAGE(PG8_SA(0, 1), a2 + hstepA, voffA);
            PG8_WAIT_L(8); PG8_BAR; PG8_WAIT_L(0); PG8_MMA(0, 0, At, B0); PG8_BAR; PG8_SCHED;
            PG8_LDB(B1, 1, 1); PG8_STAGE(PG8_SB(1, 0), b3, voffB);
            PG8_BAR; PG8_WAIT_L(0); PG8_MMA(0, 1, At, B1); PG8_BAR;
            PG8_LDA(At, 1, 1); PG8_STAGE(PG8_SA(1, 0), a3, voffA);
            PG8_BAR; PG8_WAIT_L(0); PG8_MMA(1, 0, At, B0); PG8_BAR; PG8_SCHED;
            PG8_STAGE(PG8_SB(1, 1), b3 + hstepB, voffB);
            PG8_WAIT_V(6); PG8_BAR; PG8_MMA(1, 1, At, B1); PG8_BAR;
            }
        }
        if constexpr (ALIGN_EPI) { if (wr == 0) PG8_BAR; }
        E(acc, cur, wr, wc, fr, fq);
        if (!has_next) break;
#pragma unroll
        for (int a = 0; a < 2; ++a)
#pragma unroll
            for (int b = 0; b < 2; ++b)
#pragma unroll
                for (int m = 0; m < 4; ++m)
#pragma unroll
                    for (int n = 0; n < 2; ++n) acc[a][b][m][n] = (f32x4){0.f, 0.f, 0.f, 0.f};
        cur = nxt; cA = nA; cB = nB; ++ui;
        if constexpr (ALIGN_EPI) { if (wr == 1) PG8_BAR; }
    }
    PG8_WAIT_V(0);
    if constexpr (!ALIGN_EPI) { if (wr == 0) PG8_BAR; }
    PG8_BAR;
#undef PG8_SA
#undef PG8_SB
#undef PG8_STAGE
#undef PG8_LDA
#undef PG8_LDB
#undef PG8_MMA
#undef PG8_WAIT_V
#undef PG8_WAIT_L
#undef PG8_BAR
#undef PG8_SCHED
}

__device__ __forceinline__ u32x4 pack_acc(const f32x4 v0, const f32x4 v1) { u32x4 w; w.x = cvt_pk_bf16(v0[0], v0[1]); w.y = cvt_pk_bf16(v0[2], v0[3]); w.z = cvt_pk_bf16(v1[0], v1[1]); w.w = cvt_pk_bf16(v1[2], v1[3]); return w; }

struct EpiBf16 {
    static constexpr bool PERM = true;
    bf16_t* O; int ld; bf16_t* O2 = nullptr; int rowsub = 0;
    __device__ __forceinline__ void operator()(const Acc& acc, const Unit& u, int wr, int wc, int fr, int fq) const {
        bf16_t* base = (u.z ? O2 - (size_t)rowsub * ld : O) + (size_t)(u.pm * BM + wr * 64 + fr) * ld + u.pn * BM + wc * 32 + 8 * fq;
#pragma unroll
        for (int ai = 0; ai < 2; ++ai)
#pragma unroll
            for (int m = 0; m < 4; ++m) { bf16_t* rowp = base + (size_t)(ai * HALF + m * 16) * ld;
#pragma unroll
                for (int bj = 0; bj < 2; ++bj) *(u32x4*)(rowp + bj * HALF) = pack_acc(acc[ai][bj][m][0], acc[ai][bj][m][1]); }
    }
};
struct EpiF32 {
    static constexpr bool PERM = false;
    float* C; int ld;
    __device__ __forceinline__ void operator()(const Acc& acc, const Unit& u, int wr, int wc, int fr, int fq) const {
        float* base = C + (size_t)(u.pm * BM + wr * 64 + fr) * ld + u.pn * BM + wc * 32 + 4 * fq;
#pragma unroll
        for (int ai = 0; ai < 2; ++ai)
#pragma unroll
            for (int m = 0; m < 4; ++m) { float* rowp = base + (size_t)(ai * HALF + m * 16) * ld;
#pragma unroll
                for (int bj = 0; bj < 2; ++bj)
#pragma unroll
                    for (int n = 0; n < 2; ++n) *(f32x4*)(rowp + bj * HALF + n * 16) = acc[ai][bj][m][n]; }
    }
};
struct EpiBf16z {
    static constexpr bool PERM = true;
    unsigned char* ws;
    __device__ __forceinline__ void operator()(const Acc& acc, const Unit& u, int wr, int wc, int fr, int fq) const {
        bf16_t* base = (bf16_t*)(ws + (u.z ? WS_OINTRA : WS_YOUT)) + (size_t)(u.pm * BM + wr * 64 + fr) * 2048 + u.pn * BM + wc * 32 + 8 * fq;
#pragma unroll
        for (int ai = 0; ai < 2; ++ai)
#pragma unroll
            for (int m = 0; m < 4; ++m) { bf16_t* rowp = base + (size_t)(ai * HALF + m * 16) * 2048;
#pragma unroll
                for (int bj = 0; bj < 2; ++bj) *(u32x4*)(rowp + bj * HALF) = pack_acc(acc[ai][bj][m][0], acc[ai][bj][m][1]); }
    }
};
__device__ __forceinline__ float dpp_ror1(float x) { return __int_as_float(__builtin_amdgcn_update_dpp(0, __float_as_int(x), 0x121, 0xf, 0xf, false)); }
__device__ __forceinline__ float dpp_rol1(float x) { return __int_as_float(__builtin_amdgcn_update_dpp(0, __float_as_int(x), 0x12f, 0xf, 0xf, false)); }
struct EpiFfn {
    static constexpr bool PERM = true, CARRY = false;
    bf16_t* act; bf16_t* sg; bf16_t* sv; const float* cw; const float* cb; bf16_t* upq;
    __device__ __forceinline__ void operator()(const Acc& acc, const Unit& u, int wr, int wc, int fr, int fq) const {
        if (u.z) {
            bf16_t* base = upq + (size_t)(u.pm * BM + wr * 64 + fr) * 256 + wc * 32 + 8 * fq;
#pragma unroll
            for (int ai = 0; ai < 2; ++ai)
#pragma unroll
                for (int m = 0; m < 4; ++m) { bf16_t* rowp = base + (size_t)(ai * HALF + m * 16) * 256;
#pragma unroll
                    for (int bj = 0; bj < 2; ++bj) *(u32x4*)(rowp + bj * HALF) = pack_acc(acc[ai][bj][m][0], acc[ai][bj][m][1]); }
            return;
        }
        const int chb = u.pn * 128 + wc * 32 + 8 * fq;
        float w0[8], w1[8], w2[8], bb[8];
#pragma unroll
        for (int c = 0; c < 8; ++c) { w0[c] = cw[chb + c]; w1[c] = cw[DFF + chb + c]; w2[c] = cw[2 * DFF + chb + c]; bb[c] = cb[chb + c]; }
        const bool f0 = fr == 0, f15 = fr == 15;
#pragma unroll
        for (int ai = 0; ai < 2; ++ai) {
            const int rowb = u.pm * BM + ai * HALF + wr * 64;
#pragma unroll
            for (int m = 0; m < 4; ++m) { float o[8];
#pragma unroll
                for (int c = 0; c < 8; ++c) { const int n = c >> 2, j = c & 3; const float g = acc[ai][1][m][n][j];
                    const float sendp = f15 ? (m > 0 ? acc[ai][1][m > 0 ? m - 1 : 0][n][j] : 0.f) : g, sendn = f0 ? (m < 3 ? acc[ai][1][m < 3 ? m + 1 : 3][n][j] : 0.f) : g;
                    const float prev = dpp_ror1(sendp), next = dpp_rol1(sendn);
                    const float gt = w0[c] * prev + w1[c] * g + w2[c] * next + bb[c]; o[c] = gelu_tanh_f(gt) * acc[ai][0][m][n][j]; }
                const bool bnd = (m == 0 && f0) || (m == 3 && f15);
                if (!bnd) *(u32x4*)(act + (size_t)(rowb + 16 * m + fr) * DFF + chb) = pack8(o); }
            const int span = rowb >> 6;
            if (fr < 2) { *(u32x4*)(sg + (size_t)(span * 4 + fr) * DFF + chb) = pack_acc(acc[ai][1][0][0], acc[ai][1][0][1]); if (f0) *(u32x4*)(sv + (size_t)(span * 2) * DFF + chb) = pack_acc(acc[ai][0][0][0], acc[ai][0][0][1]); }
            if (fr >= 14) { *(u32x4*)(sg + (size_t)(span * 4 + fr - 12) * DFF + chb) = pack_acc(acc[ai][1][3][0], acc[ai][1][3][1]); if (f15) *(u32x4*)(sv + (size_t)(span * 2 + 1) * DFF + chb) = pack_acc(acc[ai][0][3][0], acc[ai][0][3][1]); }
        }
    }
};
struct EpiIn {
    static constexpr bool PERM = true;
    unsigned char* ws; float* out; int layer;
    __device__ __forceinline__ void operator()(const Acc& acc, const Unit& u, int wr, int wc, int fr, int fq) const {
        const int pm = u.pm, pn = u.pn;
        if (u.z == 1) {
            bf16_t* base = (bf16_t*)(ws + WS_ZVT) + (size_t)(pm * BM + wr * 64 + fr) * R + pn * BM + wc * 32 + 8 * fq;
#pragma unroll
            for (int ai = 0; ai < 2; ++ai)
#pragma unroll
                for (int m = 0; m < 4; ++m) { bf16_t* rowp = base + (size_t)(ai * HALF + m * 16) * R;
#pragma unroll
                    for (int bj = 0; bj < 2; ++bj) *(u32x4*)(rowp + bj * HALF) = pack_acc(acc[ai][bj][m][0], acc[ai][bj][m][1]); }
            return;
        }
        if (u.z >= 2) {
            if (wc == 0) {
                float* p0 = (float*)(ws + WS_ZAP) + (size_t)(u.z - 2) * R * 32 + (size_t)(pm * BM + wr * 64 + fr) * 32 + 8 * fq;
#pragma unroll
                for (int ai = 0; ai < 2; ++ai)
#pragma unroll
                    for (int m = 0; m < 4; ++m) { float* p = p0 + (size_t)(ai * HALF + m * 16) * 32;
                        *(f32x4*)p = acc[ai][0][m][0]; *(f32x4*)(p + 4) = acc[ai][0][m][1]; }
            }
            return;
        }
        size_t boff; int ld, c0, rowadd = 0; bool f32o = false, act = false;
        if (pn < 4) { boff = WS_ZQ; ld = 1024; c0 = pn * 256; }
        else if (pn < 8) { boff = WS_ZK; ld = 1024; c0 = (pn - 4) * 256; }
        else if (pn < 16) { boff = WS_ZG; ld = 2048; c0 = (pn - 8) * 256; }
        else if (pn < 24) { boff = WS_DQ; ld = 2048; c0 = (pn - 16) * 256; }
        else if (pn < 40) { const bool isv = pn >= 32; boff = isv ? WS_DV : WS_DK; ld = 2048; c0 = (pn - (isv ? 32 : 24)) * 256;
            if (pm >= 32) rowadd = 256 * (((pm - 32) >> 3) + 1); else f32o = true; }
        else if (pn < 48) { const int cc = (pn - 40) * 256; boff = WS_ZF + (size_t)(cc >> 9) * R * 512 * 2; ld = 512; c0 = cc & 511; }
        else { boff = WS_GATE; ld = 6144; c0 = (pn - 48) * 256; act = true; }
        const int rin0 = wr * 64 + fr, cin = wc * 32 + 8 * fq;
        bf16_t* base = (bf16_t*)(ws + boff) + (size_t)(pm * BM + rowadd + rin0) * ld + c0 + cin;
#pragma unroll
        for (int ai = 0; ai < 2; ++ai)
#pragma unroll
            for (int m = 0; m < 4; ++m) { bf16_t* rowp = base + (size_t)(ai * HALF + m * 16) * ld;
#pragma unroll
                for (int bj = 0; bj < 2; ++bj) { f32x4 v0 = acc[ai][bj][m][0], v1 = acc[ai][bj][m][1];
                    if (act) {
#pragma unroll
                        for (int j = 0; j < 4; ++j) { v0[j] = sigmoid_f(v0[j]); v1[j] = sigmoid_f(v1[j]); } }
                    *(u32x4*)(rowp + bj * HALF) = pack_acc(v0, v1); } }
        if (f32o) {
            float* fb = out + (pn >= 32 ? O_NV : O_NK) + ((size_t)(pm * 2 + layer) * 256 + rin0) * 2048 + c0 + cin;
#pragma unroll
            for (int ai = 0; ai < 2; ++ai)
#pragma unroll
                for (int m = 0; m < 4; ++m) { float* fp = fb + (size_t)(ai * HALF + m * 16) * 2048;
#pragma unroll
                    for (int bj = 0; bj < 2; ++bj) { __builtin_nontemporal_store(acc[ai][bj][m][0], (f32x4*)(fp + bj * HALF)); __builtin_nontemporal_store(acc[ai][bj][m][1], (f32x4*)(fp + bj * HALF + 4)); } }
        }
    }
};
struct EpiBr {
    static constexpr bool PERM = true, CARRY = false;
    unsigned char* pbase; const bf16_t* gate;
    __device__ __forceinline__ void operator()(const Acc& acc, const Unit& u, int wr, int wc, int fr, int fq) const {
        const int zb = u.z & 3, kh = u.z >> 2;
        bf16_t* P = kh ? (bf16_t*)(pbase - WS_DQ + WS_QIN) - (size_t)RC * 2048 : (bf16_t*)(pbase + (zb == 0 ? (size_t)0 : (zb == 1 ? (WS_DK - WS_DQ) : (WS_DV - WS_DQ))));
        const int row0 = u.pm * BM + wr * 64 + fr, col0 = u.pn * BM + wc * 32 + 8 * fq;
        u32x4 gw[2][4][2];
#pragma unroll
        for (int ai = 0; ai < 2; ++ai)
#pragma unroll
            for (int m = 0; m < 4; ++m)
#pragma unroll
                for (int bj = 0; bj < 2; ++bj) gw[ai][m][bj] = *(const u32x4*)(gate + (size_t)(row0 + ai * HALF + m * 16) * 6144 + zb * 2048 + col0 + bj * HALF);
#pragma unroll
        for (int ai = 0; ai < 2; ++ai)
#pragma unroll
            for (int m = 0; m < 4; ++m) { const int row = row0 + ai * HALF + m * 16;
#pragma unroll
                for (int bj = 0; bj < 2; ++bj) { const int col = col0 + bj * HALF;
                    float gv[8]; unpack8(gw[ai][m][bj], gv);
                    f32x4 v0 = acc[ai][bj][m][0], v1 = acc[ai][bj][m][1];
#pragma unroll
                    for (int j = 0; j < 4; ++j) { v0[j] *= gv[j]; v1[j] *= gv[4 + j]; }
                    *(u32x4*)(P + (size_t)row * 2048 + col) = pack_acc(v0, v1); } }
    }
};
struct EpiY {
    static constexpr bool PERM = true;
    bf16_t* Y;
    __device__ __forceinline__ void operator()(const Acc& acc, const Unit& u, int wr, int wc, int fr, int fq) const {
        const int cs = u.pm >> 1, ch0 = (u.pm & 1) * 256, g = u.z;
        size_t off;
        if (u.pn < 32) off = (size_t)u.pn * 512 + cs * 256; else { const int bb = (u.pn - 32) >> 3, lt = (u.pn - 32) & 7; off = 16384 + (size_t)bb * 4096 + cs * 2048 + lt * 256; }
        bf16_t* base = Y + (size_t)(g * 512 + ch0 + wr * 64 + fr) * 24576 + off + wc * 32 + 8 * fq;
#pragma unroll
        for (int ai = 0; ai < 2; ++ai)
#pragma unroll
            for (int m = 0; m < 4; ++m) { bf16_t* rowp = base + (size_t)(ai * HALF + m * 16) * 24576;
#pragma unroll
                for (int bj = 0; bj < 2; ++bj) *(u32x4*)(rowp + bj * HALF) = pack_acc(acc[ai][bj][m][0], acc[ai][bj][m][1]); }
    }
};
struct EpiZaQ {
    static constexpr bool PERM = true;
    unsigned char* ws;
    __device__ __forceinline__ void operator()(const Acc& acc, const Unit& u, int wr, int wc, int fr, int fq) const {
        if (wc != 0) return;
        float* p0 = (float*)(ws + WS_ZAP) + (size_t)u.z * R * 32 + (size_t)(u.pm * BM + wr * 64 + fr) * 32 + 8 * fq;
#pragma unroll
        for (int ai = 0; ai < 2; ++ai)
#pragma unroll
            for (int m = 0; m < 4; ++m) { float* p = p0 + (size_t)(ai * HALF + m * 16) * 32;
                *(f32x4*)p = acc[ai][0][m][0]; *(f32x4*)(p + 4) = acc[ai][0][m][1]; }
    }
};
}

namespace attn {
constexpr int DH = 128, NW = 8, QBLK = 32, KVBLK = 64;
constexpr float SCALE = 0.088388347648318440f;
constexpr float THR = 8.f;
constexpr size_t SHM_V = KVBLK * DH * 2, SHM_K = KVBLK * DH * 2, SHM_ATTN = 2 * SHM_V + 2 * SHM_K + NW * 64 * 4;
#define KSWZ(row, colB) ((row) * 256 + ((colB) ^ (((row) & 7) << 4)))
#define SBAR() __builtin_amdgcn_sched_barrier(0)
__device__ __forceinline__ int crow(int r, int hi) { return (r & 3) + 8 * (r >> 2) + 4 * hi; }
__device__ __forceinline__ unsigned cvtpk(float lo, float hi) { unsigned r; asm volatile("v_cvt_pk_bf16_f32 %0, %1, %2" : "=v"(r) : "v"(lo), "v"(hi)); return r; }
__device__ __forceinline__ void partialSM(f32x16& p0, f32x16& p1, float& m_reg, float& mn, float& alpha) {
  constexpr float C = SCALE * 1.4426950408889634f;
  float pmax = p0[0];
#pragma unroll
  for (int r = 1; r < 16; ++r) pmax = fmaxf(pmax, p0[r]);
#pragma unroll
  for (int r = 0; r < 16; ++r) pmax = fmaxf(pmax, p1[r]);
  { auto rr = __builtin_amdgcn_permlane32_swap(__float_as_uint(pmax), __float_as_uint(pmax), false, false);
    pmax = fmaxf(__uint_as_float(rr[0]), __uint_as_float(rr[1])); }
  if (__builtin_expect(__all(pmax - m_reg <= THR / SCALE), 1)) { mn = m_reg; alpha = 1.f; }
  else { mn = fmaxf(m_reg, pmax); alpha = __builtin_amdgcn_exp2f((m_reg - mn) * C); m_reg = mn; }
  float mnC = -mn * C;
#pragma unroll
  for (int r = 0; r < 16; ++r) p0[r] = fmaf(p0[r], C, mnC);
#pragma unroll
  for (int r = 0; r < 16; ++r) p1[r] = fmaf(p1[r], C, mnC);
#pragma unroll
  for (int r = 0; r < 16; ++r) p0[r] = __builtin_amdgcn_exp2f(p0[r]);
}
__device__ __forceinline__ void finishSM(f32x16& p0, f32x16& p1, float alpha, float& l_reg, bf16x8& pa0, bf16x8& pa1, bf16x8& pa2, bf16x8& pa3) {
#pragma unroll
  for (int r = 0; r < 16; ++r) p1[r] = __builtin_amdgcn_exp2f(p1[r]);
  float ps = 0;
#pragma unroll
  for (int r = 0; r < 16; ++r) ps += p0[r];
#pragma unroll
  for (int r = 0; r < 16; ++r) ps += p1[r];
  { auto rr = __builtin_amdgcn_permlane32_swap(__float_as_uint(ps), __float_as_uint(ps), false, false);
    ps = __uint_as_float(rr[0]) + __uint_as_float(rr[1]); }
  l_reg = l_reg * alpha + ps;
#define PK4(P, BASE, OUT) do { unsigned a0 = cvtpk(P[BASE + 0], P[BASE + 1]), a1 = cvtpk(P[BASE + 2], P[BASE + 3]);   \
    unsigned b0 = cvtpk(P[BASE + 4], P[BASE + 5]), b1 = cvtpk(P[BASE + 6], P[BASE + 7]);                              \
    auto r0 = __builtin_amdgcn_permlane32_swap(a0, b0, false, false); auto r1 = __builtin_amdgcn_permlane32_swap(a1, b1, false, false); \
    u32x4 w = {r0[0], r1[0], r0[1], r1[1]}; OUT = *reinterpret_cast<bf16x8*>(&w); } while (0)
  PK4(p0, 0, pa0); PK4(p0, 8, pa1); PK4(p1, 0, pa2); PK4(p1, 8, pa3);
#undef PK4
}
__device__ __forceinline__ void qkt(f32x16& p0, f32x16& p1, const bf16_t* Ks, const bf16x8* qr, int r32, int hi) {
  p0 = f32x16{}; p1 = f32x16{};
#pragma unroll
  for (int d0 = 0; d0 < 8; ++d0) { int cb = (d0 * 16 + hi * 8) * 2;
    bf16x8 b0 = *reinterpret_cast<const bf16x8*>((const char*)Ks + KSWZ(r32, cb));
    bf16x8 b1 = *reinterpret_cast<const bf16x8*>((const char*)Ks + KSWZ(32 + r32, cb));
    p0 = __builtin_amdgcn_mfma_f32_32x32x16_bf16(b0, qr[d0], p0, 0, 0, 0);
    p1 = __builtin_amdgcn_mfma_f32_32x32x16_bf16(b1, qr[d0], p1, 0, 0, 0); }
}
__device__ __forceinline__ int v_st(int k, int c) { const int kk = (k & ~0xC) | ((k & 4) << 1) | ((k & 8) >> 1); return ((kk >> 3) * 4 + (c >> 5)) * 512 + ((kk & 7) * 32 + (c & 31)) * 2; }
__device__ __forceinline__ int v_rd_base(int lane) { return ((lane & 3) << 3) | (((lane >> 2) & 3) << 6) | (((lane >> 4) & 1) << 5) | (((lane >> 5) & 1) << 8); }
constexpr int v_rd_off(int d0, int ks, int half) { return d0 * 512 + ks * 4096 + half * 2048; }
template <int OFF> __device__ __forceinline__ s16x4 tr_read(int vb) {
  s16x4 r; asm volatile("ds_read_b64_tr_b16 %0, %1 offset:%2" : "=&v"(r) : "v"(vb), "i"(OFF) : "memory"); return r;
}
template <int D0> __device__ __forceinline__ void pv_one(f32x16& od, int vb, bf16x8 pa0, bf16x8 pa1, bf16x8 pa2, bf16x8 pa3) {
  const s16x4 l0 = tr_read<v_rd_off(D0, 0, 0)>(vb), h0 = tr_read<v_rd_off(D0, 0, 1)>(vb), l1 = tr_read<v_rd_off(D0, 1, 0)>(vb), h1 = tr_read<v_rd_off(D0, 1, 1)>(vb);
  const s16x4 l2 = tr_read<v_rd_off(D0, 2, 0)>(vb), h2 = tr_read<v_rd_off(D0, 2, 1)>(vb), l3 = tr_read<v_rd_off(D0, 3, 0)>(vb), h3 = tr_read<v_rd_off(D0, 3, 1)>(vb);
  asm volatile("s_waitcnt lgkmcnt(0)" ::: "memory"); SBAR();
#define PK(L, H) (bf16x8){L[0], L[1], L[2], L[3], H[0], H[1], H[2], H[3]}
  od = __builtin_amdgcn_mfma_f32_32x32x16_bf16(pa0, PK(l0, h0), od, 0, 0, 0);
  od = __builtin_amdgcn_mfma_f32_32x32x16_bf16(pa1, PK(l1, h1), od, 0, 0, 0);
  od = __builtin_amdgcn_mfma_f32_32x32x16_bf16(pa2, PK(l2, h2), od, 0, 0, 0);
  od = __builtin_amdgcn_mfma_f32_32x32x16_bf16(pa3, PK(l3, h3), od, 0, 0, 0);
#undef PK
}
__device__ __forceinline__ void pv_d0(f32x16* o, int vb, bf16x8 pa0, bf16x8 pa1, bf16x8 pa2, bf16x8 pa3) {
  pv_one<0>(o[0], vb, pa0, pa1, pa2, pa3); pv_one<1>(o[1], vb, pa0, pa1, pa2, pa3); pv_one<2>(o[2], vb, pa0, pa1, pa2, pa3); pv_one<3>(o[3], vb, pa0, pa1, pa2, pa3);
}
template <int LDQ, int LDK, int LDO>
__device__ __forceinline__ void attn_dense_body(const bf16_t* __restrict__ Qb, const bf16_t* __restrict__ Kh, const bf16_t* __restrict__ Vh, bf16_t* __restrict__ Ob, int seq, char* lds, int wave0) {
  const int tid = ltid(wave0), wid = tid >> 6, lane = tid & 63, r32 = lane & 31, hi = lane >> 5;
  bf16_t* V_lds = (bf16_t*)lds; bf16_t* K_lds = (bf16_t*)(lds + 2 * SHM_V);
  float* ws = (float*)(lds + 2 * SHM_V + 2 * SHM_K) + wid * 64; float* li_l = ws; float* al_l = ws + 32;
  float m_reg = -1e30f, l_reg = 0; f32x16 o[4] = {}; bf16x8 qr[8];
  const bf16_t* Qw = Qb + (long)(wid * QBLK + r32) * LDQ + hi * 8;
#pragma unroll
  for (int d0 = 0; d0 < 8; ++d0) qr[d0] = *reinterpret_cast<const bf16x8*>(Qw + d0 * 16);
  const int sr = tid >> 4, sc = (tid & 15) * 8, vst0 = v_st(sr, sc), vst1 = v_st(32 + sr, sc);
  const int vb0 = (int)(uintptr_t)V_lds + v_rd_base(lane);
  struct { bf16x8 vs0, vs1, ks0, ks1; } sr_[2];
#define LD8(p) (*reinterpret_cast<const bf16x8*>(p))
#define SLOAD(i, k0) do { sr_[i].vs0 = LD8(&Vh[(long)((k0) + sr) * LDK + sc]); sr_[i].vs1 = LD8(&Vh[(long)((k0) + 32 + sr) * LDK + sc]); \
    sr_[i].ks0 = LD8(&Kh[(long)((k0) + sr) * LDK + sc]); sr_[i].ks1 = LD8(&Kh[(long)((k0) + 32 + sr) * LDK + sc]); } while (0)
#define SWRITE(b, i) do { *(bf16x8*)((char*)V_lds + (b) * SHM_V + vst0) = sr_[i].vs0;          \
    *(bf16x8*)((char*)V_lds + (b) * SHM_V + vst1) = sr_[i].vs1; int kc = sc * 2;               \
    *(bf16x8*)((char*)K_lds + (b) * SHM_K + KSWZ(sr, kc)) = sr_[i].ks0;                       \
    *(bf16x8*)((char*)K_lds + (b) * SHM_K + KSWZ(32 + sr, kc)) = sr_[i].ks1; } while (0)
#define SWAIT() asm volatile("s_waitcnt vmcnt(4)" ::: "memory")
#define RESC(a) do { if (__any((a) < 1.f)) { if (hi == 0) al_l[r32] = (a); asm volatile("s_waitcnt lgkmcnt(0)" ::: "memory"); \
    _Pragma("unroll") for (int d = 0; d < 4; ++d) _Pragma("unroll") for (int r = 0; r < 16; ++r) o[d][r] *= al_l[crow(r, hi)]; } } while (0)
  f32x16 pA0, pA1, pB0, pB1; float mnA, mnB, alA, alB; bf16x8 pa0, pa1, pa2, pa3; const int NT = seq / KVBLK;
  constexpr int SE = 0, SO = 1;
  SLOAD(SE, 0); asm volatile("s_waitcnt vmcnt(0)" ::: "memory"); SWRITE(0, SE); __syncthreads();
  qkt(pA0, pA1, K_lds, qr, r32, hi); partialSM(pA0, pA1, m_reg, mnA, alA);
  SLOAD(SO, KVBLK); if (2 < NT) SLOAD(SE, 2 * KVBLK);
  SWAIT(); SWRITE(1, SO); __syncthreads();
  for (int j = 1; j + 1 < NT; j += 2) {
    SBAR(); qkt(pB0, pB1, (bf16_t*)((char*)K_lds + SHM_K), qr, r32, hi);
    finishSM(pA0, pA1, alA, l_reg, pa0, pa1, pa2, pa3); SBAR();
    SLOAD(SO, (j + 2) * KVBLK); SBAR();
    pv_d0(o, vb0, pa0, pa1, pa2, pa3); partialSM(pB0, pB1, m_reg, mnB, alB);
    __syncthreads(); SWAIT(); SWRITE(0, SE);
    RESC(alB); __syncthreads();
    SBAR(); qkt(pA0, pA1, K_lds, qr, r32, hi);
    finishSM(pB0, pB1, alB, l_reg, pa0, pa1, pa2, pa3); SBAR();
    if (j + 3 < NT) SLOAD(SE, (j + 3) * KVBLK); SBAR();
    pv_d0(o, vb0 + (int)SHM_V, pa0, pa1, pa2, pa3); partialSM(pA0, pA1, m_reg, mnA, alA);
    __syncthreads(); SWAIT(); SWRITE(1, SO);
    RESC(alA); __syncthreads();
  }
  SBAR(); qkt(pB0, pB1, (bf16_t*)((char*)K_lds + SHM_K), qr, r32, hi);
  finishSM(pA0, pA1, alA, l_reg, pa0, pa1, pa2, pa3); SBAR();
  pv_d0(o, vb0, pa0, pa1, pa2, pa3); partialSM(pB0, pB1, m_reg, mnB, alB);
  __syncthreads(); RESC(alB);
  finishSM(pB0, pB1, alB, l_reg, pa0, pa1, pa2, pa3); SBAR();
  pv_d0(o, vb0 + (int)SHM_V, pa0, pa1, pa2, pa3);
  if (hi == 0) li_l[r32] = l_reg; asm volatile("s_waitcnt lgkmcnt(0)" ::: "memory");
  float rli[16];
#pragma unroll
  for (int r = 0; r < 16; ++r) rli[r] = __builtin_amdgcn_rcpf(li_l[crow(r, hi)]);
  bf16_t* Ow = Ob + (long)(wid * QBLK) * LDO;
#pragma unroll
  for (int r = 0; r < 16; ++r) { int orow = crow(r, hi);
#pragma unroll
    for (int d0 = 0; d0 < 4; ++d0) Ow[(long)orow * LDO + d0 * 32 + r32] = (bf16_t)f2bf(o[d0][r] * rli[r]); }
#undef LD8
#undef SLOAD
#undef SWRITE
#undef SWAIT
#undef RESC
}
}

#define XB_TMO      128
#define XB_XCNT(j)  (256  + 64 * (j))
#define XB_XSUB(j)  (1280 + 64 * (j))
#define XB_XGEN(j)  (2304 + 64 * (j))
#define XB_TOP      3328
#define XB_TOPGEN   3392
#define XCD_BAR_WORDS 3456
#define XB_SPIN_CAP (1u << 18)
__device__ __forceinline__ unsigned xb_ld(unsigned* p)              { return __hip_atomic_load(p, __ATOMIC_RELAXED, __HIP_MEMORY_SCOPE_AGENT); }
__device__ __forceinline__ unsigned xb_add(unsigned* p, unsigned v) { return __hip_atomic_fetch_add(p, v, __ATOMIC_RELAXED, __HIP_MEMORY_SCOPE_AGENT); }
__device__ __forceinline__ unsigned xb_xcc_id() { return (unsigned)__builtin_amdgcn_s_getreg((3 << 11) | 20) & 0xFu; }
#define XB_SPIN(cond, bar) do { unsigned _sp = 0; while (cond) { __builtin_amdgcn_s_sleep(1); \
    if ((++_sp & 255u) == 0u) { if (xb_ld(&(bar)[XB_TMO])) break; if (_sp > XB_SPIN_CAP) { atomicAdd(&(bar)[XB_TMO], 1u); break; } } } } while (0)
struct XcdBarrier { unsigned* bar; unsigned x; volatile LAS unsigned* st; };
__device__ __forceinline__ XcdBarrier xcd_barrier_post(unsigned* bar, volatile LAS unsigned* st) {
    XcdBarrier b; b.bar = bar; b.x = xb_xcc_id(); b.st = st;
    if (threadIdx.x == 0) (void)xb_add(&bar[XB_XCNT(b.x)], 1u);
    return b;
}
__device__ __forceinline__ void xcd_barrier_complete(unsigned* bar, unsigned x, unsigned& nloc, unsigned& nx) {
    const unsigned G = gridDim.x * gridDim.y * gridDim.z;
    unsigned sum, cnt, mine, sp = 0u;
    for (;;) {
        sum = 0u; cnt = 0u; mine = 0u;
#pragma unroll
        for (unsigned j = 0; j < 16; ++j) { const unsigned c = xb_ld(&bar[XB_XCNT(j)]); sum += c; cnt += (c > 0u) ? 1u : 0u; mine = (j == x) ? c : mine; }
        if (sum == G) break;
        __builtin_amdgcn_s_sleep(1);
        if ((++sp & 255u) == 0u) { if (xb_ld(&bar[XB_TMO])) break; if (sp > XB_SPIN_CAP) { atomicAdd(&bar[XB_TMO], 1u); break; } }
    }
    nloc = mine > 0u ? mine : 1u; nx = cnt > 0u ? cnt : 1u;
}
__device__ __forceinline__ void xcd_barrier(const XcdBarrier& b) {
    asm volatile("s_waitcnt vmcnt(0)" ::: "memory");
    __syncthreads();
    if (threadIdx.x == 0) {
        GAS unsigned* barg = (GAS unsigned*)b.bar; asm volatile("" : "+s"(barg)); unsigned* bar = (unsigned*)barg;
        unsigned bx = b.x; asm volatile("" : "+s"(bx));
        __builtin_amdgcn_s_waitcnt(0);
        unsigned nloc = b.st[0], nx = b.st[1];
        if (nloc == 0u) { xcd_barrier_complete(bar, bx, nloc, nx); b.st[0] = nloc; b.st[1] = nx; }
        const unsigned old = xb_add(&bar[XB_XSUB(bx)], 1u);
        const unsigned gen = old / nloc;
        if (old + 1u == (gen + 1u) * nloc) {
            __builtin_amdgcn_fence(__ATOMIC_RELEASE, "agent");
            asm volatile("s_waitcnt vmcnt(0)" ::: "memory");
            const unsigned og = xb_add(&bar[XB_TOP], 1u);
            const unsigned tg = og / nx;
            if (og + 1u == (tg + 1u) * nx) xb_add(&bar[XB_TOPGEN], 1u);
            else XB_SPIN(xb_ld(&bar[XB_TOPGEN]) == tg, bar);
            __builtin_amdgcn_fence(__ATOMIC_ACQUIRE, "agent");
            xb_add(&bar[XB_XGEN(bx)], 1u);
            asm volatile("s_waitcnt vmcnt(0)" ::: "memory");
        } else {
            XB_SPIN(xb_ld(&bar[XB_XGEN(bx)]) == gen, bar);
            __builtin_amdgcn_fence(__ATOMIC_ACQUIRE, "agent");
            asm volatile("s_waitcnt vmcnt(0)" ::: "memory");
        }
    }
    __syncthreads();
}

constexpr int LDS_BYTES = 147456;
constexpr int LDS_MISC = 131072;
struct Args { const float* in[33]; float* out; unsigned char* ws; int ph_lo, ph_hi; };
struct Frame { const float* const* in; float* out; unsigned char* ws; LAS unsigned char* lds; int tid, lane, wave, G, bid, wave0; };
#define IN_XP 0
#define IN_XS 1
#define IN_CK 2
#define IN_CV 3
#define IN_SF 4
#define IN_SB 5
#define IN_C 6
#define IN_CCTX 7
#define IN_WMOD 8
#define IN_BMOD 9
#define IN_GPRE1 10
#define IN_GPOST1 11
#define IN_GPRE2 12
#define IN_GPOST2 13
#define IN_WIN 14
#define IN_WA2F 15
#define IN_BAF 16
#define IN_WA2B 17
#define IN_BAB 18
#define IN_GGLA 19
#define IN_LQ1 20
#define IN_LK1 21
#define IN_LQ2 22
#define IN_LK2 23
#define IN_GDIFF 24
#define IN_WBRG 25
#define IN_WBRF 26
#define IN_WBRD 27
#define IN_WOUT 28
#define IN_WUP 29
#define IN_CONVW 30
#define IN_CONVB 31
#define IN_WDOWN 32
#define WSB(off) ((bf16_t*)(F.ws + (off)))
#define WSF(off) ((float*)(F.ws + (off)))

__device__ __forceinline__ void ph_prologue(const Frame& F) {
    LAS float* red = (LAS float*)F.lds;
    const float* cctx = F.in[IN_CCTX]; const float* cc = F.in[IN_C];
    LAS float* sl = (LAS float*)(F.lds + 32768);
    for (int i = F.tid; i < 3 * 2048; i += 512) sl[i] = silu_f(i < 2048 ? cctx[i] : cc[i - 2048]);
    __syncthreads();
    for (int it = F.bid; it < 384; it += F.G) {
        const int l = it / 192, col0 = (it % 192) * 64, kg = F.tid >> 4, cq = F.tid & 15;
        const float* W = F.in[IN_WMOD] + (size_t)l * 2048 * NMOD + col0 + 4 * cq;
        f32x4 a0 = {0.f, 0.f, 0.f, 0.f}, a1 = a0, a2 = a0;
#pragma unroll 16
        for (int kk = 0; kk < 64; ++kk) { const int k = kg * 64 + kk;
            const float s0 = sl[k], s1 = sl[2048 + k], s2 = sl[4096 + k];
            const f32x4 w = *(const f32x4*)(W + (size_t)k * NMOD);
            a0 += s0 * w; a1 += s1 * w; a2 += s2 * w; }
        *(LAS f32x4*)(red + (kg * 3 + 0) * 64 + 4 * cq) = a0; *(LAS f32x4*)(red + (kg * 3 + 1) * 64 + 4 * cq) = a1; *(LAS f32x4*)(red + (kg * 3 + 2) * 64 + 4 * cq) = a2;
        __syncthreads();
        if (F.tid < 192) { const int r = F.tid >> 6, col = F.tid & 63; float s = 0.f;
            for (int k2 = 0; k2 < 32; ++k2) s += red[(k2 * 3 + r) * 64 + col];
            WSF(WS_MOD)[(size_t)(l * 3 + r) * NMOD + col0 + col] = s + F.in[IN_BMOD][(size_t)l * NMOD + col0 + col]; }
        __syncthreads();
    }
    const size_t n512 = (size_t)1024 * 512 / 8, n256 = (size_t)256 * 512 / 8, n2048 = (size_t)2048 * 4096 / 8;
    const int tb0 = F.G > 128 ? 128 : 0;
    if (F.bid >= tb0)
    for (size_t i = (size_t)(F.bid - tb0) * 512 + F.tid; i < n512 + n256 + n2048; i += (size_t)(F.G - tb0) * 512) {
        float v[8]; bf16_t* dst;
        if (i < n512) { const int m = (int)(i / 64), c0 = (int)(i % 64) * 8, ch = m & 511, cs = m >> 9;
#pragma unroll
            for (int j = 0; j < 8; ++j) { const float rev = (float)((ch * (c0 + j)) & 511) * (1.0f / 512.0f); v[j] = (cs ? __builtin_amdgcn_sinf(rev) : __builtin_amdgcn_cosf(rev)) * 0.04419417382415922f; }
            dst = WSB(WS_T512) + (size_t)m * 512 + c0;
        } else if (i < n512 + n256) { const size_t q = i - n512; const int pos = (int)(q / 64), k0 = (int)(q % 64) * 8;
#pragma unroll
            for (int j = 0; j < 8; ++j) { const int kk = k0 + j, cs = kk >> 8, l = kk & 255; const float rev = (float)((pos * l) & 255) * (1.0f / 256.0f); v[j] = (cs ? -__builtin_amdgcn_sinf(rev) : __builtin_amdgcn_cosf(rev)) * 0.0625f; }
            dst = WSB(WS_T256) + (size_t)pos * 512 + k0;
        } else { const size_t q = i - n512 - n256; const int pos = (int)(q / 512), k0 = (int)(q % 512) * 8;
#pragma unroll
            for (int j = 0; j < 8; ++j) { const int kk = k0 + j, cs = kk >> 11, l = kk & 2047; const float rev = (float)((pos * l) & 2047) * (1.0f / 2048.0f); v[j] = (cs ? -__builtin_amdgcn_sinf(rev) : __builtin_amdgcn_cosf(rev)) * 0.022097086912079608f; }
            dst = WSB(WS_T2048) + (size_t)pos * 4096 + k0;
        }
        *(u32x4*)dst = pack8(v);
    }
}

template <int RMAP = 0>
__device__ __forceinline__ void transpose_item(const float* W, int ldw, int K, int c0, int nblk, bf16_t* WT, int r0, LAS float* scr, int item, int lane) {
    const int kb = item / nblk, nb = item % nblk, k0 = 64 * kb, n0 = 32 * nb;
    const int rd0 = (RMAP == 0) ? r0 + n0 : ((n0 < DFF) ? n0 + 128 * (n0 >> 7) : (n0 - DFF) + 128 * ((n0 - DFF) >> 7) + 128);
    float tv[32]; const float* wp = W + (size_t)(k0 + (lane >> 5)) * ldw + c0 + n0 + (lane & 31);
#pragma unroll
    for (int i = 0; i < 32; ++i) tv[i] = wp[(size_t)(2 * i) * ldw];
#pragma unroll
    for (int i = 0; i < 32; ++i) scr[(2 * i + (lane >> 5)) * 33 + (lane & 31)] = tv[i];
    asm volatile("s_waitcnt lgkmcnt(0)" ::: "memory");
    const int c = lane & 7;
#pragma unroll
    for (int j = 0; j < 4; ++j) { const int n = (lane >> 3) + 8 * j; const LAS float* s = scr + (8 * c) * 33 + n;
        u32x4 o; o.x = pk2(s[0 * 33], s[1 * 33]); o.y = pk2(s[2 * 33], s[3 * 33]); o.z = pk2(s[4 * 33], s[5 * 33]); o.w = pk2(s[6 * 33], s[7 * 33]);
        *(u32x4*)(WT + (size_t)(rd0 + n) * K + k0 + 8 * c) = o; }
    asm volatile("s_waitcnt lgkmcnt(0)" ::: "memory");
}
__device__ __forceinline__ void ph_weights(const Frame& F, int l) {
    LAS float* scr = (LAS float*)(F.lds + F.wave * 8448);
    const int gw = F.bid * 8 + F.wave, NGW = F.G * 8;
    const float* win = F.in[IN_WIN] + (size_t)l * 2048 * NIN_SRC;
    bf16_t* wt = WSB(WS_WIN);
    constexpr int T_IN = 32 * 641, T_BR = 32 * 64, T_UP = 32 * 352, T_DN = 88 * 64;
    constexpr int NIT = T_IN + 3 * T_BR + T_BR + T_UP + T_DN;
    for (int it = gw; it < NIT; it += NGW) {
        int r = it;
#define SEC(Wp, ldw, Kk, c0, nc, dst, r0) { constexpr int n_ = ((Kk) / 64) * ((nc) / 32); if (r < n_) { transpose_item(Wp, ldw, Kk, c0, (nc) / 32, dst, r0, scr, r, F.lane); continue; } r -= n_; }
        SEC(win, NIN_SRC, 2048, 0, 1024, wt, 0)
        SEC(win, NIN_SRC, 2048, 1024, 1024, wt, 1024)
        SEC(win, NIN_SRC, 2048, 4128, 2048, wt, 2048)
        SEC(win, NIN_SRC, 2048, 6176, 2048, wt, 4096)
        SEC(win, NIN_SRC, 2048, 8224, 2048, wt, 6144)
        SEC(win, NIN_SRC, 2048, 10272, 2048, wt, 8192)
        SEC(win, NIN_SRC, 2048, 12320, 2048, wt, 10240)
        SEC(win, NIN_SRC, 2048, 14368, 6144, wt, 12288)
        SEC(win, NIN_SRC, 2048, 4096, 32, wt, 18432)
        SEC(win, NIN_SRC, 2048, 2048, 2048, wt, 18688)
        SEC(F.in[IN_WBRG] + (size_t)l * 2048 * 2048, 2048, 2048, 0, 2048, WSB(WS_WBR), 0)
        SEC(F.in[IN_WBRF] + (size_t)l * 2048 * 2048, 2048, 2048, 0, 2048, WSB(WS_WBR), 2048)
        SEC(F.in[IN_WBRD] + (size_t)l * 2048 * 2048, 2048, 2048, 0, 2048, WSB(WS_WBR), 4096)
        SEC(F.in[IN_WOUT] + (size_t)l * 2048 * 2048, 2048, 2048, 0, 2048, WSB(WS_WOUT), 0)
        { constexpr int n_ = 32 * 352; if (r < n_) { transpose_item<1>(F.in[IN_WUP] + (size_t)l * 2048 * NUP, NUP, 2048, 0, 352, WSB(WS_WUP), 0, scr, r, F.lane); continue; } r -= n_; }
        SEC(F.in[IN_WDOWN] + (size_t)l * DFF * 2048, 2048, DFF, 0, 2048, WSB(WS_WDOWN), 0)
#undef SEC
    }
    { u32x4* z = (u32x4*)(wt + (size_t)18464 * 2048); const size_t n = (size_t)224 * 2048 * 2 / 16;
        unsigned z0 = 0u; asm volatile("" : "+v"(z0));
        for (size_t i = (size_t)F.bid * 512 + F.tid; i < n; i += (size_t)F.G * 512) z[i] = (u32x4){z0, z0, z0, z0}; }
}

__device__ __forceinline__ const float* x_row(const Frame& F, int l, int m) {
    if (l == 0) return m < RC ? F.in[IN_XP] + (size_t)m * D : F.in[IN_XS] + (size_t)(m - RC) * D;
    return F.out + (size_t)m * D;
}
__device__ __forceinline__ const float* mod_row(const Frame& F, int l, int m) { const int cond = m < RC ? 0 : 1 + ((m - RC) >> 11); return WSF(WS_MOD) + (size_t)(l * 3 + cond) * NMOD; }
__device__ __forceinline__ void ph_norm1(const Frame& F, int l) {
    const int gw = F.bid * 8 + F.wave, NGW = F.G * 8;
    const float* g = F.in[IN_GPRE1] + (size_t)l * D;
    for (int m0 = gw; m0 < R; m0 += 2 * NGW) {
        const bool ok1 = m0 + NGW < R; const int mm[2] = {m0, ok1 ? m0 + NGW : m0};
        f32x4 v[2][8];
#pragma unroll
        for (int u = 0; u < 2; ++u) { const f32x4* xr = (const f32x4*)x_row(F, l, mm[u]) + F.lane;
#pragma unroll
            for (int j = 0; j < 8; ++j) v[u][j] = xr[64 * j]; }
#pragma unroll
        for (int u = 0; u < 2; ++u) { float ss = 0.f;
#pragma unroll
            for (int j = 0; j < 8; ++j) ss += (v[u][j].x * v[u][j].x + v[u][j].y * v[u][j].y) + (v[u][j].z * v[u][j].z + v[u][j].w * v[u][j].w);
            const float rinv = rsqrtf(wave_sum(ss, F.lane) * (1.0f / D) + EPS); const float* md = mod_row(F, l, mm[u]);
            u32x2* o = (u32x2*)(WSB(WS_H) + (size_t)mm[u] * D) + F.lane;
            if (u == 0 || ok1) {
#pragma unroll
                for (int j = 0; j < 8; ++j) { const int c = 256 * j + 4 * F.lane; const f32x4 gg = *(const f32x4*)(g + c), sh = *(const f32x4*)(md + c), sc = *(const f32x4*)(md + 2048 + c);
                    const f32x4 y = v[u][j] * rinv * gg * (1.0f + sc) + sh; u32x2 w; w.x = pk2(y.x, y.y); w.y = pk2(y.z, y.w); o[64 * j] = w; } } }
    }
}
__device__ __forceinline__ void ph_cache(const Frame& F, int l) {
    const int gw = F.bid * 8 + F.wave, NGW = F.G * 8;
    for (int i = gw; i < 1024; i += NGW) { const int t = i >> 9, b = (i >> 8) & 1, j = i & 255;
        const f32x4* src = (const f32x4*)((t ? F.in[IN_CV] : F.in[IN_CK]) + ((size_t)(b * 2 + l) * 256 + j) * D) + F.lane;
        u32x2* o = (u32x2*)(WSB(t ? WS_DV : WS_DK) + (size_t)(RC + b * 2304 + j) * D) + F.lane;
#pragma unroll
        for (int jj = 0; jj < 8; ++jj) { const f32x4 y = src[64 * jj]; u32x2 w; w.x = pk2(y.x, y.y); w.y = pk2(y.z, y.w); o[64 * jj] = w; }
    }
}
template <bool XBF>
__device__ __forceinline__ void ph_mid(const Frame& F, int l) {
    const int gw = F.bid * 8 + F.wave, NGW = F.G * 8;
    const float* gp1 = F.in[IN_GPOST1] + (size_t)l * D; const float* g2 = F.in[IN_GPRE2] + (size_t)l * D;
    for (int m0 = gw; m0 < R; m0 += 2 * NGW) {
        const bool ok1 = m0 + NGW < R; const int mm[2] = {m0, ok1 ? m0 + NGW : m0};
        u32x2 yw[2][8], yw2[2][8]; f32x4 xv[2][8]; u32x2 xw[2][8];
#pragma unroll
        for (int u = 0; u < 2; ++u) { const u32x2* yr = (const u32x2*)(WSB(WS_YOUT) + (size_t)mm[u] * D) + F.lane;
            if constexpr (XBF) { const u32x2* xr = (const u32x2*)(WSB(WS_XB2) + (size_t)mm[u] * D) + F.lane;
#pragma unroll
                for (int j = 0; j < 8; ++j) { yw[u][j] = yr[64 * j]; xw[u][j] = xr[64 * j]; }
            } else { const f32x4* xr = (const f32x4*)x_row(F, 0, mm[u]) + F.lane;
#pragma unroll
                for (int j = 0; j < 8; ++j) { yw[u][j] = yr[64 * j]; xv[u][j] = xr[64 * j]; } }
            const bool latr = mm[u] >= RC; const u32x2* yr2 = (const u32x2*)(WSB(WS_KENDT) + (size_t)(latr ? mm[u] - RC : 0) * D) + F.lane;
#pragma unroll
            for (int j = 0; j < 8; ++j) yw2[u][j] = latr ? yr2[64 * j] : (u32x2){0u, 0u}; }
#pragma unroll
        for (int u = 0; u < 2; ++u) { const float* md = mod_row(F, l, mm[u]); f32x4 y[8]; float ss = 0.f;
#pragma unroll
            for (int j = 0; j < 8; ++j) { y[j] = (f32x4){lo16(yw[u][j].x) + lo16(yw2[u][j].x), hi16(yw[u][j].x) + hi16(yw2[u][j].x), lo16(yw[u][j].y) + lo16(yw2[u][j].y), hi16(yw[u][j].y) + hi16(yw2[u][j].y)}; ss += (y[j].x * y[j].x + y[j].y * y[j].y) + (y[j].z * y[j].z + y[j].w * y[j].w); }
            const float rinv = rsqrtf(wave_sum(ss, F.lane) * (1.0f / D) + EPS);
            float s2 = 0.f; u32x2* xo = (u32x2*)(WSB(WS_X1B) + (size_t)mm[u] * D) + F.lane; const bool st = (u == 0 || ok1);
#pragma unroll
            for (int j = 0; j < 8; ++j) { const int c = 256 * j + 4 * F.lane; const f32x4 gg = *(const f32x4*)(gp1 + c), gt = *(const f32x4*)(md + 4096 + c);
                f32x4 xin; if constexpr (XBF) xin = (f32x4){lo16(xw[u][j].x), hi16(xw[u][j].x), lo16(xw[u][j].y), hi16(xw[u][j].y)}; else xin = xv[u][j];
                const f32x4 x1 = xin + gt * (y[j] * rinv * gg); y[j] = x1; if (st) { u32x2 w; w.x = pk2(x1.x, x1.y); w.y = pk2(x1.z, x1.w); xo[64 * j] = w; } s2 += (x1.x * x1.x + x1.y * x1.y) + (x1.z * x1.z + x1.w * x1.w); }
            const float rinv2 = rsqrtf(wave_sum(s2, F.lane) * (1.0f / D) + EPS);
            u32x2* o = (u32x2*)(WSB(WS_H) + (size_t)mm[u] * D) + F.lane;
            if (st) {
#pragma unroll
                for (int j = 0; j < 8; ++j) { const int c = 256 * j + 4 * F.lane; const f32x4 gg = *(const f32x4*)(g2 + c), sh = *(const f32x4*)(md + 6144 + c), sc = *(const f32x4*)(md + 8192 + c);
                    const f32x4 h = y[j] * rinv2 * gg * (1.0f + sc) + sh; u32x2 w; w.x = pk2(h.x, h.y); w.y = pk2(h.z, h.w); o[64 * j] = w; } } }
    }
}
template <bool NEXT>
__device__ __forceinline__ void ph_final(const Frame& F, int l) {
    const int gw = F.bid * 8 + F.wave, NGW = F.G * 8;
    const float* gp2 = F.in[IN_GPOST2] + (size_t)l * D; const float* g1n = F.in[IN_GPRE1] + (size_t)(l + 1) * D;
    for (int m0 = gw; m0 < R; m0 += 2 * NGW) {
        const bool ok1 = m0 + NGW < R; const int mm[2] = {m0, ok1 ? m0 + NGW : m0};
        u32x2 ya[2][8], yb[2][8], xw[2][8];
#pragma unroll
        for (int u = 0; u < 2; ++u) { const u32x2* yr = (const u32x2*)(WSB(WS_YOUT) + (size_t)mm[u] * D) + F.lane; const u32x2* yr1 = (const u32x2*)(WSB(WS_OINTRA) + (size_t)mm[u] * D) + F.lane; const u32x2* xr = (const u32x2*)(WSB(WS_X1B) + (size_t)mm[u] * D) + F.lane;
#pragma unroll
            for (int j = 0; j < 8; ++j) { ya[u][j] = yr[64 * j]; yb[u][j] = (mm[u] >= RC) ? yr1[64 * j] : (u32x2){0u, 0u}; xw[u][j] = xr[64 * j]; } }
#pragma unroll
        for (int u = 0; u < 2; ++u) { const float* md = mod_row(F, l, mm[u]); f32x4 y[8]; float ss = 0.f;
#pragma unroll
            for (int j = 0; j < 8; ++j) { y[j] = (f32x4){lo16(ya[u][j].x) + lo16(yb[u][j].x), hi16(ya[u][j].x) + hi16(yb[u][j].x), lo16(ya[u][j].y) + lo16(yb[u][j].y), hi16(ya[u][j].y) + hi16(yb[u][j].y)}; ss += (y[j].x * y[j].x + y[j].y * y[j].y) + (y[j].z * y[j].z + y[j].w * y[j].w); }
            const float rinv = rsqrtf(wave_sum(ss, F.lane) * (1.0f / D) + EPS);
            f32x4* xo = (f32x4*)(F.out + (size_t)mm[u] * D) + F.lane; u32x2* xo2 = (u32x2*)(WSB(WS_XB2) + (size_t)mm[u] * D) + F.lane; float s2 = 0.f; const bool st = (u == 0 || ok1);
#pragma unroll
            for (int j = 0; j < 8; ++j) { const int c = 256 * j + 4 * F.lane; const f32x4 gg = *(const f32x4*)(gp2 + c), gt = *(const f32x4*)(md + 10240 + c);
                const f32x4 xin = (f32x4){lo16(xw[u][j].x), hi16(xw[u][j].x), lo16(xw[u][j].y), hi16(xw[u][j].y)};
                const f32x4 x2 = xin + gt * (y[j] * rinv * gg);
                if (st) { if constexpr (NEXT) { u32x2 w; w.x = pk2(x2.x, x2.y); w.y = pk2(x2.z, x2.w); xo2[64 * j] = w; } else xo[64 * j] = x2; }
                y[j] = x2; s2 += (x2.x * x2.x + x2.y * x2.y) + (x2.z * x2.z + x2.w * x2.w); }
            if constexpr (NEXT) {
                const float rinv2 = rsqrtf(wave_sum(s2, F.lane) * (1.0f / D) + EPS); const float* mdn = mod_row(F, l + 1, mm[u]);
                u32x2* o = (u32x2*)(WSB(WS_H) + (size_t)mm[u] * D) + F.lane;
                if (st) {
#pragma unroll
                    for (int j = 0; j < 8; ++j) { const int c = 256 * j + 4 * F.lane; const f32x4 gg = *(const f32x4*)(g1n + c), sh = *(const f32x4*)(mdn + c), sc = *(const f32x4*)(mdn + 2048 + c);
                        const f32x4 h = y[j] * rinv2 * gg * (1.0f + sc) + sh; u32x2 w; w.x = pk2(h.x, h.y); w.y = pk2(h.z, h.w); o[64 * j] = w; } }
            } }
    }
}
__device__ __forceinline__ float diff_lambda(const Frame& F, int l, float& lam_init) {
    const float* q1 = F.in[IN_LQ1] + l * 128; const float* k1 = F.in[IN_LK1] + l * 128; const float* q2 = F.in[IN_LQ2] + l * 128; const float* k2 = F.in[IN_LK2] + l * 128;
    const float s1 = wave_sum(q1[F.lane] * k1[F.lane] + q1[64 + F.lane] * k1[64 + F.lane], F.lane);
    const float s2 = wave_sum(q2[F.lane] * k2[F.lane] + q2[64 + F.lane] * k2[64 + F.lane], F.lane);
    lam_init = 0.8f - 0.6f * __expf(-0.3f * (float)l);
    return __expf(s1) - __expf(s2) + lam_init;
}
__device__ __forceinline__ void ph_postmix(const Frame& F, int l) {
    const int gw = F.bid * 8 + F.wave, NGW = F.G * 8;
    float lam_init; const float lam = diff_lambda(F, l, lam_init);
    const float* ggla = F.in[IN_GGLA] + (size_t)l * 512 + 8 * F.lane; const float* gdiff = F.in[IN_GDIFF] + (size_t)l * 256 + 8 * (F.lane & 31);
    float gg[8], gd[8];
#pragma unroll
    for (int j = 0; j < 8; ++j) { gg[j] = ggla[j]; gd[j] = gdiff[j]; }
    for (int m = gw; m < R; m += NGW) {
        const size_t ro = (size_t)m * D + 8 * F.lane; const size_t po = (size_t)m * 4096 + (F.lane >> 5) * 512 + (F.lane & 31) * 8;
        u32x4 wa[4], wb[4], wc[4], wz[4], p1[4], p2[4];
#pragma unroll
        for (int q = 0; q < 4; ++q) { wa[q] = *(const u32x4*)(WSB(WS_OINTRA) + ro + 512 * q); wb[q] = *(const u32x4*)(WSB(WS_OF) + ro + 512 * q); wc[q] = *(const u32x4*)(WSB(WS_OB) + ro + 512 * q);
            wz[q] = *(const u32x4*)(WSB(WS_ZG) + ro + 512 * q); p1[q] = *(const u32x4*)(WSB(WS_OPART) + po + 1024 * q); p2[q] = *(const u32x4*)(WSB(WS_OPART) + po + 1024 * q + 256); }
#pragma unroll
        for (int q = 0; q < 4; ++q) {
            float a[8], b[8], c[8], zg[8], r[8]; unpack8(wa[q], a); unpack8(wb[q], b); unpack8(wc[q], c); unpack8(wz[q], zg); float ss = 0.f;
#pragma unroll
            for (int j = 0; j < 8; ++j) { a[j] += b[j] + c[j]; ss += a[j] * a[j]; }
            const float rinv = rsqrtf(wave_sum(ss, F.lane) * (1.0f / 512.0f) + EPS);
#pragma unroll
            for (int j = 0; j < 8; ++j) r[j] = a[j] * rinv * gg[j] * silu_f(zg[j]);
            *(u32x4*)(WSB(WS_AGLA) + ro + 512 * q) = pack8(r); }
#pragma unroll
        for (int q = 0; q < 4; ++q) {
            float a[8], b[8], r[8]; unpack8(p1[q], a); unpack8(p2[q], b); float ss = 0.f;
#pragma unroll
            for (int j = 0; j < 8; ++j) { a[j] -= lam * b[j]; ss += a[j] * a[j]; }
            ss += shx(ss, 1, F.lane); ss += shx(ss, 2, F.lane); ss += shx(ss, 4, F.lane); ss += shx(ss, 8, F.lane); ss += shx(ss, 16, F.lane);
            const float rinv = rsqrtf(ss * (1.0f / 256.0f) + EPS) * (1.0f - lam_init);
#pragma unroll
            for (int j = 0; j < 8; ++j) r[j] = a[j] * rinv * gd[j];
            *(u32x4*)(WSB(WS_ADIFF) + ro + 512 * q) = pack8(r); }
    }
}
__device__ __forceinline__ void ph_merge(const Frame& F) {
    const size_t n = (size_t)R * D / 8, st = (size_t)F.G * 512;
    const u32x4* p0 = (const u32x4*)(F.ws + WS_DQ); const u32x4* p1 = (const u32x4*)(F.ws + WS_DK); const u32x4* p2 = (const u32x4*)(F.ws + WS_DV); const u32x4* p3 = (const u32x4*)(F.ws + WS_QIN); u32x4* o = (u32x4*)(F.ws + WS_MERGED);
    for (size_t i = (size_t)F.bid * 512 + F.tid; i < n; i += 2 * st) { const size_t i2 = i + st; const bool has2 = i2 < n; const size_t j2 = has2 ? i2 : i;
        constexpr size_t lat0 = (size_t)RC * D / 8; const u32x4 zz = {0u, 0u, 0u, 0u};
        const u32x4 a0 = p0[i], b0 = p1[i], c0 = p2[i], a1 = p0[j2], b1 = p1[j2], c1 = p2[j2];
        const u32x4 d0 = i >= lat0 ? p3[i - lat0] : zz, d1 = j2 >= lat0 ? p3[j2 - lat0] : zz;
        float a[8], b[8], c[8], d[8]; unpack8(a0, a); unpack8(b0, b); unpack8(c0, c); unpack8(d0, d);
#pragma unroll
        for (int j = 0; j < 8; ++j) a[j] += (b[j] + c[j]) + d[j];
        o[i] = pack8(a);
        unpack8(a1, a); unpack8(b1, b); unpack8(c1, c); unpack8(d1, d);
#pragma unroll
        for (int j = 0; j < 8; ++j) a[j] += (b[j] + c[j]) + d[j];
        if (has2) o[i2] = pack8(a); }
}
__device__ __forceinline__ void ph_conv(const Frame& F, int l) {
    constexpr int NS = DFF / 8; const size_t n = (size_t)NS * (R / 32);
    const float* cw = F.in[IN_CONVW] + (size_t)l * 3 * DFF; const float* cb = F.in[IN_CONVB] + (size_t)l * DFF;
    const bf16_t* sg = WSB(WS_SG); const bf16_t* sv = WSB(WS_SV); bf16_t* A = WSB(WS_ACT);
    for (size_t i = (size_t)F.bid * 512 + F.tid; i < n; i += (size_t)F.G * 512) {
        const int j0 = (int)(i % NS) * 8, br = (int)(i / NS), q = br >> 1, last = br & 1, r = q * 64 + (last ? 63 : 0);
        if (r < 256 || (r < 512 && j0 < 2560)) continue;
        const int s = r < RC ? (r & 255) : ((r - RC) & 2047), Ls = r < RC ? 256 : 2048;
        const u32x4 zz = {0u, 0u, 0u, 0u};
        u32x4 gp, gc, gn, vv;
        if (!last) { gc = *(const u32x4*)(sg + (size_t)(q * 4 + 0) * DFF + j0); gn = *(const u32x4*)(sg + (size_t)(q * 4 + 1) * DFF + j0); gp = (s > 0) ? *(const u32x4*)(sg + (size_t)(q * 4 - 1) * DFF + j0) : zz; vv = *(const u32x4*)(sv + (size_t)(q * 2) * DFF + j0); }
        else { gc = *(const u32x4*)(sg + (size_t)(q * 4 + 3) * DFF + j0); gp = *(const u32x4*)(sg + (size_t)(q * 4 + 2) * DFF + j0); gn = (s < Ls - 1) ? *(const u32x4*)(sg + (size_t)(q * 4 + 4) * DFF + j0) : zz; vv = *(const u32x4*)(sv + (size_t)(q * 2 + 1) * DFF + j0); }
        float g0[8], g1[8], g2[8], val[8], rr[8]; unpack8(gp, g0); unpack8(gc, g1); unpack8(gn, g2); unpack8(vv, val);
#pragma unroll
        for (int j = 0; j < 8; ++j) { const float gt = g0[j] * cw[j0 + j] + g1[j] * cw[DFF + j0 + j] + g2[j] * cw[2 * DFF + j0 + j] + cb[j0 + j]; rr[j] = gelu_tanh_f(gt) * val[j]; }
        *(u32x4*)(A + (size_t)r * DFF + j0) = pack8(rr);
    }
    const bf16_t* P = WSB(WS_UPQ);
    for (int i = F.bid * 512 + F.tid; i < 64 * 256 * 16; i += F.G * 512) {
        const int t = i >> 12, r = (i >> 4) & 255, c0 = (i & 15) * 8, pm = t < 44 ? 0 : 1, pn = t < 44 ? t : t - 44, ch = pn * 128 + c0;
        float val[8], g0[8], g1[8], g2[8], rr[8];
#pragma unroll
        for (int j = 0; j < 8; ++j) { val[j] = 0.f; g0[j] = 0.f; g1[j] = 0.f; g2[j] = 0.f; }
        const u32x4 zz = {0u, 0u, 0u, 0u};
        u32x4 lv[4], lp[4], lc[4], ln[4];
#pragma unroll
        for (int kq = 0; kq < 4; ++kq) { const bf16_t* pr = P + ((size_t)(kq * 64 + t) * 256 + r) * 256 + c0;
            lv[kq] = *(const u32x4*)pr; lc[kq] = *(const u32x4*)(pr + 128); lp[kq] = (r > 0) ? *(const u32x4*)(pr + 128 - 256) : zz; ln[kq] = (r < 255) ? *(const u32x4*)(pr + 128 + 256) : zz; }
#pragma unroll
        for (int kq = 0; kq < 4; ++kq) { float a[8]; unpack8(lv[kq], a);
#pragma unroll
            for (int j = 0; j < 8; ++j) val[j] += a[j];
            unpack8(lp[kq], a);
#pragma unroll
            for (int j = 0; j < 8; ++j) g0[j] += a[j];
            unpack8(lc[kq], a);
#pragma unroll
            for (int j = 0; j < 8; ++j) g1[j] += a[j];
            unpack8(ln[kq], a);
#pragma unroll
            for (int j = 0; j < 8; ++j) g2[j] += a[j]; }
#pragma unroll
        for (int j = 0; j < 8; ++j) { const float gt = g0[j] * cw[ch + j] + g1[j] * cw[DFF + ch + j] + g2[j] * cw[2 * DFF + ch + j] + cb[ch + j]; rr[j] = gelu_tanh_f(gt) * val[j]; }
        *(u32x4*)(A + (size_t)(pm * 256 + r) * DFF + ch) = pack8(rr);
    }
}
__device__ __forceinline__ void ph_rope(const Frame& F) {
    const size_t n = (size_t)RL * 256;
    for (size_t i = (size_t)F.bid * 512 + F.tid; i < n; i += (size_t)F.G * 512) {
        const int rl = (int)(i >> 8), w = (int)(i & 255), isk = w >> 7, blk = (w >> 3) & 15, ax = (w >> 2) & 1, f0 = (w & 3) * 8;
        const int b = rl >> 11, s = rl & 2047; const float pos = (float)(ax ? (s & 63) : (s >> 6));
        bf16_t* p = (isk ? WSB(WS_DK) + (size_t)(RC + b * 2304 + 256 + s) * D : WSB(WS_DQ) + (size_t)(RC + rl) * D) + blk * 128 + ax * 64 + f0;
        float x1[8], x2[8], o1[8], o2[8]; unpack8(*(const u32x4*)p, x1); unpack8(*(const u32x4*)(p + 32), x2);
#pragma unroll
        for (int j = 0; j < 8; ++j) { const float inv = exp2f(-(float)(f0 + j) * (13.287712379549449f / 32.0f)); const float rev = pos * inv * 0.15915494309189535f;
            const float cs = __builtin_amdgcn_cosf(rev), sn = __builtin_amdgcn_sinf(rev); o1[j] = x1[j] * cs - x2[j] * sn; o2[j] = x2[j] * cs + x1[j] * sn; }
        *(u32x4*)p = pack8(o1); *(u32x4*)(p + 32) = pack8(o2);
    }
}

constexpr int GP_QIN = 0, GP_KIN = 33792, GP_AL = 67584, GP_X = 33792, GP_ZA = 100352, GP_TOT = 108800;
constexpr int GP_XS = 260, GP_ZS = 33;
template <int DIR>
__device__ __forceinline__ void gla_pre_dir(const Frame& F, int l, int item, int tok0, int h, f32x4 (&Aacc)[2], const u32x4 (&tq)[4], const u32x4 (&tk)[4], const float (&aw)[2][4], const float bias) {
    LAS bf16_t* qin = (LAS bf16_t*)(F.lds + GP_QIN); LAS bf16_t* kin = (LAS bf16_t*)(F.lds + GP_KIN); LAS float* tot = (LAS float*)(F.lds + GP_TOT); const LAS float* zal = (const LAS float*)(F.lds + GP_ZA);
    const int d = F.tid & 255, half = F.tid >> 8;
#pragma unroll
    for (int i = 0; i < 4; ++i) { const int p = F.tid + 512 * i, row = p >> 5, c16 = p & 31; *(LAS u32x4*)(qin + row * 264 + c16 * 8) = tq[i]; }
    {   LAS float* X = (LAS float*)(F.lds + GP_X);
        const int fr = F.lane & 15, fq = F.lane >> 4;
#pragma unroll
        for (int tt = 0; tt < 4; ++tt) { float bz[4];
#pragma unroll
            for (int s4 = 0; s4 < 4; ++s4) bz[s4] = zal[(16 * tt + fr) * GP_ZS + DIR * 16 + 4 * s4 + fq];
#pragma unroll
            for (int ct = 0; ct < 2; ++ct) { f32x4 acc = {0.f, 0.f, 0.f, 0.f};
#pragma unroll
                for (int s4 = 0; s4 < 4; ++s4) acc = __builtin_amdgcn_mfma_f32_16x16x4f32(aw[ct][s4], bz[s4], acc, 0, 0, 0);
                *(LAS f32x4*)(X + (16 * tt + fr) * GP_XS + 32 * F.wave + 16 * ct + 4 * fq) = acc; } } }
    __syncthreads();
    float cum[32]; float run = 0.f;
    {   const LAS float* xb = (const LAS float*)(F.lds + GP_X) + (32 * half) * GP_XS + d;
#pragma unroll
        for (int jj = 0; jj < 32; ++jj) { const float x = xb[(DIR ? 31 - jj : jj) * GP_XS] + bias; run += logsig_f(x) * 0.0625f; cum[jj] = run; } }
    tot[half * 256 + d] = run;
    __syncthreads();
#pragma unroll
    for (int i = 0; i < 4; ++i) { const int p = F.tid + 512 * i, row = p >> 5, c16 = p & 31; *(LAS u32x4*)(kin + row * 264 + c16 * 8) = tk[i]; }
    const int first = DIR ? 1 : 0; const float off = (half == first) ? 0.f : tot[first * 256 + d]; const float blast = tot[d] + tot[256 + d];
    const float ebl = __expf(blast);
    if (half == 0) WSF(WS_DECAY)[(size_t)(item * 2 + DIR) * 256 + d] = ebl;
    __syncthreads();
    LAS bf16_t* qb = qin + (32 * half) * 264 + d; LAS bf16_t* kb = kin + (32 * half) * 264 + d;
    bf16_t* ke_g = WSB(WS_KENDT) + ((size_t)(item * 2 + DIR) * 256 + d) * 64 + 32 * half;
#pragma unroll
    for (int g8 = 0; g8 < 4; ++g8) { float ke[8];
#pragma unroll
        for (int j8 = 0; j8 < 8; ++j8) { const int jj = 8 * g8 + j8; const int tl = (DIR ? 31 - jj : jj); const float b = cum[jj] + off;
            const float q = bf2f(qb[tl * 264]) * 0.0625f, k = bf2f(kb[tl * 264]);
            const float eb = __expf(b), ieb = __builtin_amdgcn_rcpf(eb); const float qi = q * eb, ki = k * ieb; ke[j8] = ki * ebl;
            qb[tl * 264] = (bf16_t)f2bf(qi); kb[tl * 264] = (bf16_t)f2bf(ki); if ((j8 & 1) == 1) asm volatile("" ::: "memory"); }
        u32x4 pk; int t0;
        if (DIR == 0) { pk.x = pk2(ke[0], ke[1]); pk.y = pk2(ke[2], ke[3]); pk.z = pk2(ke[4], ke[5]); pk.w = pk2(ke[6], ke[7]); t0 = 8 * g8; }
        else { pk.x = pk2(ke[7], ke[6]); pk.y = pk2(ke[5], ke[4]); pk.z = pk2(ke[3], ke[2]); pk.w = pk2(ke[1], ke[0]); t0 = 24 - 8 * g8; }
        *(u32x4*)(ke_g + t0) = pk; asm volatile("" ::: "memory"); }
    __syncthreads();
    {   bf16_t* qg = WSB(WS_QIN) + (size_t)DIR * R * 1024 + (size_t)tok0 * 1024 + h * 256;
#pragma unroll
        for (int i = 0; i < 4; ++i) { const int p = F.tid + 512 * i, row = p >> 5, c16 = p & 31;
            *(u32x4*)(qg + (size_t)row * 1024 + c16 * 8) = *(const LAS u32x4*)(qin + row * 264 + c16 * 8); } }
    const int tm = F.wave >> 1, lr = F.lane & 15, lq = F.lane >> 4;
#pragma unroll
    for (int t2 = 0; t2 < 2; ++t2) { const int tn = 2 * (F.wave & 1) + t2; f32x4 acc = {0.f, 0.f, 0.f, 0.f};
#pragma unroll
        for (int ks = 0; ks < 8; ++ks) { const bf16x8 a = *(const LAS bf16x8*)(qin + (16 * tm + lr) * 264 + 32 * ks + 8 * lq); const bf16x8 b = *(const LAS bf16x8*)(kin + (16 * tn + lr) * 264 + 32 * ks + 8 * lq);
            acc = __builtin_amdgcn_mfma_f32_16x16x32_bf16(a, b, acc, 0, 0, 0); }
#pragma unroll
        for (int i = 0; i < 4; ++i) { const int t = 16 * tm + 4 * lq + i, s = 16 * tn + lr; const bool keep = DIR ? (s >= t) : (s <= t); Aacc[t2][i] += keep ? acc[i] : 0.f; } }
    __syncthreads();
}
__device__ __forceinline__ void gla_pre_item(const Frame& F0, int l, int item) {
    Frame F = F0; F.tid = ltid(F.wave0); F.lane = F.tid & 63; F.wave = F.wave0;
    const int ch = item >> 2, h = item & 3, tok0 = ch * 64;
    LAS float* zal = (LAS float*)(F.lds + GP_ZA); LAS bf16_t* Al = (LAS bf16_t*)(F.lds + GP_AL);
    const int tm = F.wave >> 1, lr = F.lane & 15, lq = F.lane >> 4;
    f32x4 z4;
    {   const f32x4* zp_ = (const f32x4*)(WSF(WS_ZAP) + (size_t)tok0 * 32) + F.tid; constexpr size_t qs = (size_t)R * 32 / 4;
        const f32x4 z0 = zp_[0], z1 = zp_[qs], z2 = zp_[2 * qs], z3 = zp_[3 * qs]; z4 = (z0 + z1) + (z2 + z3); }
    u32x4 tq[4], tk[4];
    {   const bf16_t* zq = WSB(WS_ZQ) + (size_t)tok0 * 1024 + h * 256; const bf16_t* zk = WSB(WS_ZK) + (size_t)tok0 * 1024 + h * 256;
#pragma unroll
        for (int i = 0; i < 4; ++i) { const int p = F.tid + 512 * i, row = p >> 5, c16 = p & 31; tq[i] = *(const u32x4*)(zq + (size_t)row * 1024 + c16 * 8); tk[i] = *(const u32x4*)(zk + (size_t)row * 1024 + c16 * 8); } }
    bf16x8 va0[4], va1[4];
    {   const bf16_t* vt = WSB(WS_ZVT);
#pragma unroll
        for (int v4 = 0; v4 < 4; ++v4) { const bf16_t* vp = vt + (size_t)(h * 512 + 16 * (4 * F.wave + v4) + lr) * R + tok0 + 8 * lq; va0[v4] = *(const bf16x8*)vp; va1[v4] = *(const bf16x8*)(vp + 32); } }
    float awf[2][4], awb[2][4];
    {   const float* wf = F.in[IN_WA2F] + (size_t)l * 16 * 1024 + h * 256 + 32 * F.wave + lr; const float* wb = F.in[IN_WA2B] + (size_t)l * 16 * 1024 + h * 256 + 32 * F.wave + lr;
#pragma unroll
        for (int ct = 0; ct < 2; ++ct)
#pragma unroll
            for (int s4 = 0; s4 < 4; ++s4) { awf[ct][s4] = wf[(size_t)(4 * s4 + lq) * 1024 + 16 * ct]; awb[ct][s4] = wb[(size_t)(4 * s4 + lq) * 1024 + 16 * ct]; } }
    const float biasf = F.in[IN_BAF][(size_t)l * 1024 + h * 256 + (F.tid & 255)], biasb = F.in[IN_BAB][(size_t)l * 1024 + h * 256 + (F.tid & 255)];
    { LAS float* zp = zal + (F.tid >> 3) * GP_ZS + (F.tid & 7) * 4; zp[0] = z4.x; zp[1] = z4.y; zp[2] = z4.z; zp[3] = z4.w; }
    __syncthreads();
    f32x4 Aacc[2] = {{0.f, 0.f, 0.f, 0.f}, {0.f, 0.f, 0.f, 0.f}};
    gla_pre_dir<0>(F, l, item, tok0, h, Aacc, tq, tk, awf, biasf);
    gla_pre_dir<1>(F, l, item, tok0, h, Aacc, tq, tk, awb, biasb);
#pragma unroll
    for (int t2 = 0; t2 < 2; ++t2) { const int tn = 2 * (F.wave & 1) + t2;
#pragma unroll
        for (int i = 0; i < 4; ++i) Al[(16 * tm + 4 * lq + i) * 72 + 16 * tn + lr] = (bf16_t)f2bf(Aacc[t2][i]); }
    __syncthreads();
    bf16_t* oi = WSB(WS_OINTRA);
#pragma unroll
    for (int v4 = 0; v4 < 4; ++v4) { const int vtile = 4 * F.wave + v4;
        const bf16x8 a0 = va0[v4], a1 = va1[v4];
#pragma unroll
        for (int tt = 0; tt < 4; ++tt) { const bf16x8 b0 = *(const LAS bf16x8*)(Al + (16 * tt + lr) * 72 + 8 * lq), b1 = *(const LAS bf16x8*)(Al + (16 * tt + lr) * 72 + 32 + 8 * lq);
            f32x4 acc = {0.f, 0.f, 0.f, 0.f}; acc = __builtin_amdgcn_mfma_f32_16x16x32_bf16(a0, b0, acc, 0, 0, 0); acc = __builtin_amdgcn_mfma_f32_16x16x32_bf16(a1, b1, acc, 0, 0, 0);
            u32x2 w; w.x = pk2(acc[0], acc[1]); w.y = pk2(acc[2], acc[3]);
            *(u32x2*)(oi + (size_t)(tok0 + 16 * tt + lr) * D + h * 512 + 16 * vtile + 4 * lq) = w; } }
    __syncthreads();
}
constexpr int GS_Q = 0, GS_K = 65536, GS_D = 102400;
__device__ __forceinline__ void gla_scan_item(const Frame& F0, int l, int id) {
    Frame F = F0; F.tid = ltid(F.wave0); F.lane = F.tid & 63; F.wave = F.wave0;
    const bool lat = id < 32; const int j = lat ? id : id - 32;
    const int vs = j & 1, dir = (j >> 1) & 1, h = (j >> 2) & 3, b = j >> 4;
    const int cbase = lat ? 128 + 32 * b : 4 * b, nch = lat ? 32 : 4;
    LAS unsigned char* qsb = F.lds + GS_Q; LAS bf16_t* ksm = (LAS bf16_t*)(F.lds + GS_K); LAS float* dl = (LAS float*)(F.lds + GS_D);
    const int lr0 = F.lane & 15, lq0 = F.lane >> 4; const int vcol0 = h * 512 + vs * 256 + 32 * F.wave;
    f32x4 S[16][2];
    const size_t soff = ((size_t)((b * 2 + l) * 4 + h) * 256) * 512 + vs * 256 + 32 * F.wave + lr0;
    if (lat) { const float* st = F.in[dir ? IN_SB : IN_SF] + soff;
#pragma unroll
        for (int mt = 0; mt < 16; ++mt)
#pragma unroll
            for (int i = 0; i < 4; ++i) { S[mt][0][i] = st[(size_t)(16 * mt + 4 * lq0 + i) * 512]; S[mt][1][i] = st[(size_t)(16 * mt + 4 * lq0 + i) * 512 + 16]; if (i == 3) asm volatile("" ::: "memory"); }
    } else {
#pragma unroll
        for (int mt = 0; mt < 16; ++mt) { S[mt][0] = (f32x4){0.f, 0.f, 0.f, 0.f}; S[mt][1] = (f32x4){0.f, 0.f, 0.f, 0.f}; } }
    const bf16_t* qing = WSB(WS_QIN) + (size_t)dir * R * 1024 + h * 256; bf16_t* og = dir ? WSB(WS_OB) : WSB(WS_OF);
    u32x4 pk[4]; f32x4 pd; bf16x8 pv00, pv01, pv10, pv11;
#define GS_DMA_Q(ci_, T_) do { const int qrow0 = 2 * F.wave + (((T_) & 63) >> 5), qcp = (T_) & 31; const int gch_ = cbase + (dir ? nch - 1 - (ci_) : (ci_)); const bf16_t* qb_ = qing + (size_t)gch_ * 64 * 1024; \
        _Pragma("unroll") for (int i = 0; i < 4; ++i) { const int row_ = qrow0 + 16 * i, c_ = (qcp & 16) | ((qcp ^ row_) & 15); \
            __builtin_amdgcn_global_load_lds((const unsigned*)(qb_ + (size_t)row_ * 1024 + c_ * 8), (LAS unsigned*)(qsb + ((ci_) & 1) * 32768 + (8 * i + F.wave) * 1024), 16, 0, 0); } } while (0)
#define GS_LOAD_K(ci_, T_) do { const int lr_ = (T_) & 15, lq_ = ((T_) >> 4) & 3; const int gch_ = cbase + (dir ? nch - 1 - (ci_) : (ci_)), tok0_ = gch_ * 64, item_ = gch_ * 4 + h; \
        const bf16_t* keg_ = WSB(WS_KENDT) + (size_t)(item_ * 2 + dir) * 256 * 64; \
        _Pragma("unroll") for (int i = 0; i < 4; ++i) { const int p = (T_) + 512 * i; pk[i] = *(const u32x4*)(keg_ + (size_t)(p >> 3) * 64 + (p & 7) * 8); } \
        pd = *(const f32x4*)(WSF(WS_DECAY) + (size_t)(item_ * 2 + dir) * 256 + 4 * ((T_) & 63)); \
        const bf16_t* vp_ = WSB(WS_ZVT) + (size_t)(vcol0 + lr_) * R + tok0_ + 8 * lq_; pv00 = *(const bf16x8*)vp_; pv01 = *(const bf16x8*)(vp_ + 32); \
        pv10 = *(const bf16x8*)(vp_ + (size_t)16 * R); pv11 = *(const bf16x8*)(vp_ + (size_t)16 * R + 32); } while (0)
    GS_DMA_Q(0, F.tid); GS_LOAD_K(0, F.tid);
    for (int ci = 0; ci < nch; ++ci) {
        const int gch = cbase + (dir ? nch - 1 - ci : ci), tok0 = gch * 64;
        int tidc = F.tid; asm volatile("" : "+v"(tidc));
        const int lr = tidc & 15, lq = (tidc >> 4) & 3;
        asm volatile("s_waitcnt vmcnt(0)" ::: "memory");
#pragma unroll
        for (int i = 0; i < 4; ++i) { const int p = tidc + 512 * i; *(LAS u32x4*)(ksm + (p >> 3) * 72 + (p & 7) * 8) = pk[i]; }
        if (tidc < 64) *(LAS f32x4*)(dl + 4 * tidc) = pd;
        const bf16x8 vt00 = pv00, vt01 = pv01, vt10 = pv10, vt11 = pv11;
        __syncthreads();
        if (ci + 1 < nch) { GS_DMA_Q(ci + 1, tidc); GS_LOAD_K(ci + 1, tidc); }
        const LAS unsigned char* qs = qsb + (ci & 1) * 32768;
        f32x4 O[4][2];
#pragma unroll
        for (int tt = 0; tt < 4; ++tt) { O[tt][0] = (f32x4){0.f, 0.f, 0.f, 0.f}; O[tt][1] = (f32x4){0.f, 0.f, 0.f, 0.f}; }
#pragma unroll
        for (int ks = 0; ks < 8; ++ks) {
            u32x4 aw0, aw1;
            aw0.x = pk2(S[2 * ks][0][0], S[2 * ks][0][1]); aw0.y = pk2(S[2 * ks][0][2], S[2 * ks][0][3]); aw0.z = pk2(S[2 * ks + 1][0][0], S[2 * ks + 1][0][1]); aw0.w = pk2(S[2 * ks + 1][0][2], S[2 * ks + 1][0][3]);
            aw1.x = pk2(S[2 * ks][1][0], S[2 * ks][1][1]); aw1.y = pk2(S[2 * ks][1][2], S[2 * ks][1][3]); aw1.z = pk2(S[2 * ks + 1][1][0], S[2 * ks + 1][1][1]); aw1.w = pk2(S[2 * ks + 1][1][2], S[2 * ks + 1][1][3]);
            const bf16x8 af0 = __builtin_bit_cast(bf16x8, aw0), af1 = __builtin_bit_cast(bf16x8, aw1);
            const int c0 = 4 * ks + (lq >> 1), c1 = c0 + 2;
            const int o0 = ((c0 & 16) | ((c0 ^ lr) & 15)) * 16 + (lq & 1) * 8, o1 = ((c1 & 16) | ((c1 ^ lr) & 15)) * 16 + (lq & 1) * 8;
#pragma unroll
            for (int tt = 0; tt < 4; ++tt) { const LAS unsigned char* qp = qs + (16 * tt + lr) * 512;
                const u32x2 lo = *(const LAS u32x2*)(qp + o0), hi = *(const LAS u32x2*)(qp + o1); u32x4 bw; bw.x = lo.x; bw.y = lo.y; bw.z = hi.x; bw.w = hi.y; const bf16x8 bf = __builtin_bit_cast(bf16x8, bw);
                O[tt][0] = __builtin_amdgcn_mfma_f32_16x16x32_bf16(af0, bf, O[tt][0], 0, 0, 0); O[tt][1] = __builtin_amdgcn_mfma_f32_16x16x32_bf16(af1, bf, O[tt][1], 0, 0, 0); }
            asm volatile("" ::: "memory"); }
#pragma unroll
        for (int tt = 0; tt < 4; ++tt)
#pragma unroll
            for (int nt2 = 0; nt2 < 2; ++nt2) { u32x2 w; w.x = pk2(O[tt][nt2][0], O[tt][nt2][1]); w.y = pk2(O[tt][nt2][2], O[tt][nt2][3]);
                *(u32x2*)(og + (size_t)(tok0 + 16 * tt + lr) * D + vcol0 + 16 * nt2 + 4 * lq) = w; }
#pragma unroll
        for (int mt = 0; mt < 16; ++mt) { const f32x4 dv = *(const LAS f32x4*)(dl + 16 * mt + 4 * lq); S[mt][0] = S[mt][0] * dv; S[mt][1] = S[mt][1] * dv;
            const bf16x8 a0 = *(const LAS bf16x8*)(ksm + (16 * mt + lr) * 72 + 8 * lq), a1 = *(const LAS bf16x8*)(ksm + (16 * mt + lr) * 72 + 32 + 8 * lq);
            S[mt][0] = __builtin_amdgcn_mfma_f32_16x16x32_bf16(a0, vt00, S[mt][0], 0, 0, 0); S[mt][0] = __builtin_amdgcn_mfma_f32_16x16x32_bf16(a1, vt01, S[mt][0], 0, 0, 0);
            S[mt][1] = __builtin_amdgcn_mfma_f32_16x16x32_bf16(a0, vt10, S[mt][1], 0, 0, 0); S[mt][1] = __builtin_amdgcn_mfma_f32_16x16x32_bf16(a1, vt11, S[mt][1], 0, 0, 0);
            if (mt & 1) asm volatile("" ::: "memory"); }
        __syncthreads();
    }
#undef GS_DMA_Q
#undef GS_LOAD_K
    if (!lat) { const int te = ltid(F.wave0), lre = te & 15, lqe = (te >> 4) & 3;
        float* so = F.out + (dir ? O_SB : O_SF) + ((size_t)((b * 2 + l) * 4 + h) * 256) * 512 + vs * 256 + 32 * F.wave + lre;
#pragma unroll
        for (int mt = 0; mt < 16; ++mt)
#pragma unroll
            for (int i = 0; i < 4; ++i) { __builtin_nontemporal_store(S[mt][0][i], so + (size_t)(16 * mt + 4 * lqe + i) * 512); __builtin_nontemporal_store(S[mt][1][i], so + (size_t)(16 * mt + 4 * lqe + i) * 512 + 16); if (i == 3) asm volatile("" ::: "memory"); } }
}

__device__ __forceinline__ void attn_item(const Frame& F, int u) {
    int rowq, rowk, seq, h, c, vh;
    if (u < 512) { vh = u & 1; c = (u >> 1) & 1; const int qb = (u >> 2) & 7; h = (u >> 5) & 7; const int b = u >> 8; rowq = RC + b * 2048 + qb * 256; rowk = RC + b * 2304; seq = 2304; }
    else { const int v = u - 512; vh = v & 1; c = (v >> 1) & 1; h = (v >> 2) & 7; const int b = v >> 5; rowq = b * 256; rowk = b * 256; seq = 256; }
    const int rowqk = (u < 512) ? rowq : rowq;
    const bf16_t* Q = WSB(WS_DQ) + (size_t)rowqk * D + h * 256 + c * 128; const bf16_t* Kp = WSB(WS_DK) + (size_t)rowk * D + h * 256 + c * 128; const bf16_t* Vp = WSB(WS_DV) + (size_t)rowk * D + h * 256 + vh * 128;
    bf16_t* O = WSB(WS_OPART) + (size_t)rowq * 4096 + h * 512 + c * 256 + vh * 128;
    attn::attn_dense_body<2048, 2048, 4096>(Q, Kp, Vp, O, seq, (char*)F.lds, F.wave0);
    __syncthreads();
}

struct SchedIn { int G, c; const char* H; const char* W;
    __device__ __forceinline__ bool next(int i, pg8::Unit& u) const { const long L = (long)i * G + c; if (L >= 4032) return false;
        if (L >= 3840) { const int q = (int)L - 3840, pm = q >> 2, kq = q & 3;
            u.a = H + (size_t)pm * 256 * 2048 * 2 + (size_t)kq * 1024; u.b = W + (size_t)72 * 256 * 2048 * 2 + (size_t)kq * 1024; u.pm = pm; u.pn = 72; u.z = 2 + kq; u.nt = 8; return true; }
        const int x = (int)(L & 7), j = (int)(L >> 3);
        if (j < 432) { const int br = j >> 5, s = j & 31; int b, pnh = 0;
            if (br < 13) b = br * 8 + x; else { b = 104 + (x >> 1); pnh = 4 * (x & 1); }
            const int pm = 4 * (b % 12) + (s & 3), pn = 8 * (b / 12) + pnh + (s >> 2);
            u.a = H + (size_t)pm * 256 * 2048 * 2; u.b = W + (size_t)pn * 256 * 2048 * 2; u.pm = pm; u.pn = pn; u.z = 0; }
        else { const int jz = j - 432; int zb, s, pnh = 0;
            if (jz < 16) { zb = 8 + (x >> 1); s = jz; pnh = 4 * (x & 1); } else { zb = x; s = jz - 16; }
            const int pm = 4 * (zb & 1) + (s & 3), pn = 8 * (zb >> 1) + pnh + (s >> 2);
            u.a = W + (size_t)(NIN_MAIN + pm * 256) * 2048 * 2; u.b = H + (size_t)pn * 256 * 2048 * 2; u.pm = pm; u.pn = pn; u.z = 1; }
        return true; } };
struct SchedZa { int c; const char* H; const char* W;
    __device__ __forceinline__ bool next(int i, pg8::Unit& u) const { if (i != 0 || c >= 192) return false; const int pm = c >> 2, kq = c & 3;
        u.a = H + (size_t)pm * 256 * 2048 * 2 + (size_t)kq * 1024; u.b = W + (size_t)72 * 256 * 2048 * 2 + (size_t)kq * 1024; u.pm = pm; u.pn = 72; u.z = kq; return true; } };
struct SchedOne { pg8::Unit u0;
    __device__ __forceinline__ bool next(int i, pg8::Unit& u) const { if (i != 0) return false; u = u0; return true; } };
struct SchedBr { int G, c; const char* ws; int mode;
    __device__ __forceinline__ bool next(int i, pg8::Unit& u) const {
        int z, pm, pn; size_t koff = 0;
        const long L = (long)i * G + c; if (L >= 1280) return false;
        if (L < 768) { z = (int)L / 384; pg8::tile_order((int)L % 384, 48, 8, pm, pn); } else if (L < 1024) { z = 2; pg8::tile_order((int)L - 768, 32, 8, pm, pn); }
        else { const int cc = (int)L - 1024, kh = cc & 1, t = cc >> 1; pm = 32 + (t >> 3); pn = t & 7; z = 2 | (kh << 2); koff = (size_t)kh * 1024 * 2; u.nt = 16; }
        const int zb = z & 3; const size_t aoff = (zb == 0) ? WS_AGLA : ((zb == 1) ? WS_OFNET : WS_ADIFF);
        u.a = ws + aoff + (size_t)pm * 256 * 2048 * 2 + koff; u.b = ws + WS_WBR + (size_t)(zb * 2048 + pn * 256) * 2048 * 2 + koff; u.pm = pm; u.pn = pn; u.z = z; return true; } };
struct SchedOut { int G, c; const char* A; const char* B;
    __device__ __forceinline__ bool next(int i, pg8::Unit& u) const { const long L = (long)i * G + c; if (L >= 512) return false;
        if (L < 256) { int pm, pn; pg8::tile_order((int)L, 32, 8, pm, pn); u.a = A + (size_t)pm * 256 * 2048 * 2; u.b = B + (size_t)pn * 256 * 2048 * 2; u.pm = pm; u.pn = pn; u.z = 0; return true; }
        const int cc = (int)L - 256, kh = cc & 1, t = cc >> 1, pm = 32 + (t >> 3), pn = t & 7;
        u.a = A + (size_t)pm * 256 * 2048 * 2 + (size_t)kh * 2048; u.b = B + (size_t)pn * 256 * 2048 * 2 + (size_t)kh * 2048; u.pm = pm; u.pn = pn; u.z = kh; u.nt = 16; return true; } };
struct SchedOutHalf { int c; const char* A; const char* B;
    __device__ __forceinline__ bool next(int i, pg8::Unit& u) const { if (i != 0 || c >= 256) return false; const int kh = c & 1, t = c >> 1, pm = 32 + (t >> 3), pn = t & 7;
        u.a = A + (size_t)pm * 256 * 2048 * 2 + (size_t)kh * 2048; u.b = B + (size_t)pn * 256 * 2048 * 2 + (size_t)kh * 2048; u.pm = pm; u.pn = pn; u.z = kh; return true; } };
struct SchedPlain { int G, c, nM, nN; const char* A; const char* B; size_t sa, sb;
    __device__ __forceinline__ bool next(int i, pg8::Unit& u) const { const long L = (long)i * G + c; if (L >= (long)nM * nN) return false;
        int pm, pn; pg8::tile_order((int)L, nM, nN, pm, pn); u.a = A + (size_t)pm * sa; u.b = B + (size_t)pn * sb; u.pm = pm; u.pn = pn; u.z = 0; return true; } };
struct SchedUp { int G, c; const char* A; const char* B;
    __device__ __forceinline__ bool next(int i, pg8::Unit& u) const { const long L = (long)i * G + c; if (L >= 2304) return false;
        if (L >= 2048) { const int q = (int)L - 2048, t = q >> 2, kq = q & 3, pm = t < 44 ? 0 : 1, pn = t < 44 ? t : t - 44;
            u.a = A + (size_t)pm * 256 * 2048 * 2 + (size_t)kq * 1024; u.b = B + (size_t)pn * 256 * 2048 * 2 + (size_t)kq * 1024; u.pm = kq * 64 + t; u.pn = 0; u.z = 1; u.nt = 8; return true; }
        int pm, pn; if (L < 2024) { pg8::tile_order((int)L, 46, 44, pm, pn); pm += 2; } else { pm = 1; pn = 20 + ((int)L - 2024); }
        u.a = A + (size_t)pm * 256 * 2048 * 2; u.b = B + (size_t)pn * 256 * 2048 * 2; u.pm = pm; u.pn = pn; u.z = 0; return true; } };
struct SchedUpQ { int c; const char* A; const char* B;
    __device__ __forceinline__ bool next(int i, pg8::Unit& u) const { if (i != 0 || c >= 256) return false; const int t = c >> 2, kq = c & 3, pm = t < 44 ? 0 : 1, pn = t < 44 ? t : t - 44;
        u.a = A + (size_t)pm * 256 * 2048 * 2 + (size_t)kq * 1024; u.b = B + (size_t)pn * 256 * 2048 * 2 + (size_t)kq * 1024; u.pm = kq * 64 + t; u.pn = 0; u.z = 0; return true; } };
struct SchedDown { int G, c; const char* A; const char* B;
    __device__ __forceinline__ bool next(int i, pg8::Unit& u) const { const long L = (long)i * G + c; if (L >= 512) return false;
        if (L < 256) { int pm, pn; pg8::tile_order((int)L, 32, 8, pm, pn); u.a = A + (size_t)pm * 256 * DFF * 2; u.b = B + (size_t)pn * 256 * DFF * 2; u.pm = pm; u.pn = pn; u.z = 0; return true; }
        const int cc = (int)L - 256, z = cc & 1, t = cc >> 1, pm = 32 + (t >> 3), pn = t & 7;
        u.a = A + ((size_t)pm * 256 * DFF + (size_t)z * (DFF / 2)) * 2; u.b = B + ((size_t)pn * 256 * DFF + (size_t)z * (DFF / 2)) * 2; u.pm = pm; u.pn = pn; u.z = z; u.nt = 44; return true; } };
struct SchedF1 { int G, c; const char* T; const char* ZF;
    __device__ __forceinline__ bool next(int i, pg8::Unit& u) const { const long L = (long)i * G + c; if (L >= 768) return false;
        const int z = (int)L / 192, r = (int)L % 192, pm = r & 3, pn = r >> 2;
        u.a = T + (size_t)pm * 256 * 512 * 2; u.b = ZF + ((size_t)z * R + (size_t)pn * 256) * 512 * 2; u.pm = pm; u.pn = pn; u.z = z; return true; } };
struct SchedF2c { int G, c; const char* T; const char* Y;
    __device__ __forceinline__ bool next(int i, pg8::Unit& u) const { const long L = (long)i * G + c; if (L >= 256) return false;
        const int b = (int)L >> 3, pn = (int)L & 7; u.a = T; u.b = Y + ((size_t)pn * 256 * 24576 + (size_t)b * 512) * 2; u.pm = b; u.pn = pn; u.z = 0; return true; } };
struct SchedF2l { int G, c; const char* T; const char* Y;
    __device__ __forceinline__ bool next(int i, pg8::Unit& u) const { const long L = (long)i * G + c; if (L >= 128) return false;
        const int b = (int)L >> 6, p8 = ((int)L >> 3) & 7, pn = (int)L & 7;
        u.a = T + (size_t)p8 * 256 * 4096 * 2; u.b = Y + ((size_t)pn * 256 * 24576 + 16384 + (size_t)b * 4096) * 2; u.pm = 32 + b * 8 + p8; u.pn = pn; u.z = 0; return true; } };

__global__ void __launch_bounds__(512, 2) mega(Args args) {
    extern __shared__ __attribute__((aligned(16))) unsigned char lds_raw[];
    Frame F; F.in = args.in; F.out = args.out; F.ws = args.ws; F.lds = (LAS unsigned char*)lds_raw;
    F.wave0 = __builtin_amdgcn_readfirstlane((int)threadIdx.x >> 6); F.tid = ltid(F.wave0); F.lane = F.tid & 63; F.wave = F.wave0; F.G = gridDim.x; F.bid = blockIdx.x;
    unsigned* ctl = (unsigned*)(F.ws + WS_CTL);
    for (int u = F.tid; u < (LDS_BYTES - LDS_MISC) / 4; u += 512) ((LAS unsigned*)(F.lds + LDS_MISC))[u] = 0u;
    __syncthreads();
    const int lo = args.ph_lo, hi = args.ph_hi;
    XcdBarrier bar; bar.bar = ctl + CW_BAR; bar.x = 0; bar.st = nullptr;
    if (hi - lo > 1) bar = xcd_barrier_post(ctl + CW_BAR, (volatile LAS unsigned*)(F.lds + LDS_MISC + 32));
#ifndef PH_MASK
#define PH_MASK 0x3fff
#endif
#define RELAUNDER() do { F.tid = ltid(F.wave0); F.lane = F.tid & 63; F.wave = F.wave0; { int b_ = (int)blockIdx.x; asm volatile("" : "+s"(b_)); F.bid = b_; } { GAS unsigned char* w_ = (GAS unsigned char*)args.ws; asm volatile("" : "+s"(w_)); F.ws = (unsigned char*)w_; } { GAS float* o_ = (GAS float*)args.out; asm volatile("" : "+s"(o_)); F.out = (float*)o_; } } while (0)
#ifndef PROBE_REP
#define PROBE_REP 0
#endif
#define REPS(j) ((((PROBE_REP) >> (j)) & 1) ? 2 : 1)
#define IN(k) (lo <= (k) && (k) < hi)
#define INJ(j) ((((PH_MASK) >> ((j) + 1)) & 1) && IN(pb + (j)))
#define SEAM(k) do { if (IN(k) && IN((k) + 1)) xcd_barrier(bar); } while (0)
    if ((PH_MASK & 1) && IN(0)) { RELAUNDER(); ph_prologue(F); } SEAM(0);
    for (int l = 0; l < 2; ++l) {
        const int pb = 1 + 13 * l;
        if (l == 0) { if (INJ(0)) { RELAUNDER(); ph_weights(F, 0); RELAUNDER(); ph_norm1(F, 0); ph_cache(F, 0); } SEAM(pb + 0); }
        if (INJ(1)) { for (int rep_ = 0; rep_ < REPS(1); ++rep_) { RELAUNDER();
            pg8::Gemm g{2048, 2048, 2048}; SchedIn S{F.G, F.bid, (const char*)F.ws + WS_H, (const char*)F.ws + WS_WIN};
            pg8::EpiIn E{F.ws, F.out, l};
            pg8::gemm_phase<pg8::EpiIn, SchedIn, true, true>(F.lds, g, S, E, F.wave0);
            }
        } SEAM(pb + 1);
        if (INJ(2)) { RELAUNDER();
#ifndef SUB
#define SUB 0xff
#endif
            if (SUB & 1) for (int rep_ = 0; rep_ < REPS(2); ++rep_) for (int it = F.bid; it < 768; it += F.G) gla_pre_item(F, l, it);
            RELAUNDER();
            if (SUB & 2) ph_rope(F);
            RELAUNDER();
            if (SUB & 4) for (int rep_ = 0; rep_ < REPS(2); ++rep_) { RELAUNDER();
            pg8::Gemm g{512, 512, 512}; SchedF1 S{F.G, F.bid, (const char*)F.ws + WS_T512, (const char*)F.ws + WS_ZF}; pg8::EpiY E{WSB(WS_Y)};
            pg8::gemm_phase<pg8::EpiY, SchedF1, true, true>(F.lds, g, S, E, F.wave0); }
        } SEAM(pb + 2);
        if (INJ(3)) { RELAUNDER();
            { pg8::Gemm g{4096, 24576, 4096}; SchedF2l S{F.G, F.bid, (const char*)F.ws + WS_T2048, (const char*)F.ws + WS_Y}; pg8::EpiBf16 E{WSB(WS_OFNET), 2048};
              pg8::gemm_phase<pg8::EpiBf16, SchedF2l, true, true>(F.lds, g, S, E, F.wave0); }
            RELAUNDER();
            {   LAS int* qslot = (LAS int*)(F.lds + LDS_MISC + 64);
                for (;;) {
                    if (F.tid == 0) *qslot = (int)__hip_atomic_fetch_add(ctl + CW_Q + 64 * l, 1u, __ATOMIC_RELAXED, __HIP_MEMORY_SCOPE_AGENT);
                    __syncthreads(); const int id = *qslot; __syncthreads();
                    if (id >= 2080) break;
                    if (id < 32 || (id >= 544 && id < 1056)) gla_scan_item(F, l, id < 32 ? id : id - 544 + 32);
                    else attn_item(F, id < 544 ? id - 32 : id - 1056 + 512);
                }
            }
            RELAUNDER();
            { pg8::Gemm g{512, 24576, 512}; SchedF2c S{F.G, F.bid, (const char*)F.ws + WS_T256, (const char*)F.ws + WS_Y}; pg8::EpiBf16 E{WSB(WS_OFNET), 2048};
              pg8::gemm_phase<pg8::EpiBf16, SchedF2c, true, true>(F.lds, g, S, E, F.wave0); }
        } SEAM(pb + 3);
        if (INJ(4)) { for (int rep_ = 0; rep_ < REPS(4); ++rep_) { RELAUNDER(); ph_postmix(F, l); } } SEAM(pb + 4);
        if (INJ(5)) { for (int rep_ = 0; rep_ < REPS(5); ++rep_) { RELAUNDER();
            { pg8::Gemm g{2048, 2048, 2048}; SchedBr S{F.G, F.bid, (const char*)F.ws, 0}; pg8::EpiBr E{F.ws + WS_P, WSB(WS_GATE)};
              pg8::gemm_phase<pg8::EpiBr, SchedBr, true, true>(F.lds, g, S, E, F.wave0); } }
        } SEAM(pb + 5);
        if (INJ(6)) { for (int rep_ = 0; rep_ < REPS(6); ++rep_) { RELAUNDER(); ph_merge(F); } } SEAM(pb + 6);
        if (INJ(7)) { for (int rep_ = 0; rep_ < REPS(7); ++rep_) { RELAUNDER();
            { pg8::Gemm g{2048, 2048, 2048}; SchedOut S{F.G, F.bid, (const char*)F.ws + WS_MERGED, (const char*)F.ws + WS_WOUT}; pg8::EpiBf16 E{WSB(WS_YOUT), 2048, WSB(WS_KENDT), RC};
              pg8::gemm_phase<pg8::EpiBf16, SchedOut, true, true>(F.lds, g, S, E, F.wave0); } }
        } SEAM(pb + 7);
        if (INJ(8)) { RELAUNDER(); if (l == 0) ph_mid<false>(F, 0); else ph_mid<true>(F, 1); } SEAM(pb + 8);
        if (INJ(9)) { for (int rep_ = 0; rep_ < REPS(9); ++rep_) { RELAUNDER();
            pg8::Gemm g{2048, 2048, 2048}; SchedUp S{F.G, F.bid, (const char*)F.ws + WS_H, (const char*)F.ws + WS_WUP}; pg8::EpiFfn E{WSB(WS_ACT), WSB(WS_SG), WSB(WS_SV), F.in[IN_CONVW] + (size_t)l * 3 * DFF, F.in[IN_CONVB] + (size_t)l * DFF, WSB(WS_UPQ)};
            pg8::gemm_phase<pg8::EpiFfn, SchedUp, true, true>(F.lds, g, S, E, F.wave0);
            }
        } SEAM(pb + 9);
        if (INJ(10)) { for (int rep_ = 0; rep_ < REPS(10); ++rep_) { RELAUNDER(); ph_conv(F, l); } } SEAM(pb + 10);
        if (INJ(11)) { for (int rep_ = 0; rep_ < REPS(11); ++rep_) { RELAUNDER();
            pg8::Gemm g{DFF, DFF, DFF}; SchedDown S{F.G, F.bid, (const char*)F.ws + WS_ACT, (const char*)F.ws + WS_WDOWN}; pg8::EpiBf16z E{F.ws};
            pg8::gemm_phase<pg8::EpiBf16z, SchedDown, true, true>(F.lds, g, S, E, F.wave0); }
        } SEAM(pb + 11);
        if (INJ(12)) { RELAUNDER();
            if (l == 0) { ph_weights(F, 1); RELAUNDER(); ph_final<true>(F, 0); ph_cache(F, 1); } else ph_final<false>(F, 1); }
        if (l == 0) { if (IN(pb + 12) && IN(pb + 14)) xcd_barrier(bar); }
    }
#undef IN
#undef SEAM
}

extern "C" void kernel_launch(void* const* d_in, const int* in_sizes, int n_in, void* d_out, int out_size, void* d_ws, size_t ws_size, hipStream_t stream) {
    static int grid = 0;
    if (grid == 0) {
        if (n_in != 33 || (size_t)out_size != O_END || ws_size < WS_END) { fprintf(stderr, "kernel_launch: unexpected shapes (n_in %d out %d ws %zu)\n", n_in, out_size, ws_size); grid = -1; return; }
        int dev = 0, cus = 0, per_cu = 0;
        if (hipGetDevice(&dev) != hipSuccess || hipDeviceGetAttribute(&cus, hipDeviceAttributeMultiprocessorCount, dev) != hipSuccess) { grid = -1; return; }
        if (hipFuncSetAttribute((const void*)mega, hipFuncAttributeMaxDynamicSharedMemorySize, LDS_BYTES) != hipSuccess) { fprintf(stderr, "kernel_launch: hipFuncSetAttribute failed\n"); grid = -1; return; }
        if (hipOccupancyMaxActiveBlocksPerMultiprocessor(&per_cu, (const void*)mega, 512, LDS_BYTES) != hipSuccess || per_cu < 1) { fprintf(stderr, "kernel_launch: occupancy query says %d\n", per_cu); }
        (void)hipGetLastError();
        grid = cus;
    }
    if (grid < 0) return;
    (void)hipMemsetAsync((char*)d_ws + WS_CTL, 0, CTL_BYTES, stream);
    Args a{};
    for (int i = 0; i < 33; ++i) a.in[i] = (const float*)d_in[i];
    a.out = (float*)d_out; a.ws = (unsigned char*)d_ws;
#if MK_MODE == 0
    a.ph_lo = 0; a.ph_hi = NPH;
    hipLaunchKernelGGL(mega, dim3(grid), dim3(512), LDS_BYTES, stream, a);
#else
    for (int p = 0; p < NPH; ++p) { a.ph_lo = p; a.ph_hi = p + 1; hipLaunchKernelGGL(mega, dim3(grid), dim3(512), LDS_BYTES, stream, a); }
#endif
}
```

```cpp
#include <hip/hip_runtime.h>
#include <cstdio>
#include <cstdint>

#ifndef MK_MODE
#define MK_MODE 0
#endif
#ifndef MK_DBG
#define MK_DBG 0
#endif

#define LAS __attribute__((address_space(3)))
#define GAS __attribute__((address_space(1)))
typedef unsigned short bf16_t;
typedef short bf16x8 __attribute__((ext_vector_type(8)));
typedef short s16x4 __attribute__((ext_vector_type(4)));
typedef float f32x4 __attribute__((ext_vector_type(4)));
typedef float f32x2 __attribute__((ext_vector_type(2)));
typedef float f32x8 __attribute__((ext_vector_type(8)));
typedef float f32x16 __attribute__((ext_vector_type(16)));
typedef unsigned u32x4 __attribute__((ext_vector_type(4)));
typedef unsigned u32x2 __attribute__((ext_vector_type(2)));

constexpr int D = 2048, RC = 8192, RL = 4096, R = 12288, NBC = 32, LC = 256, NBL = 2, LL = 2048, PAST = 256;
constexpr int DFF = 5632, NUP = 11264, NMOD = 12288, NIN_SRC = 20512, NIN_MAIN = 18688, NIN_PAD = 20736;
constexpr int KROWS = RC + NBL * (PAST + LL);
constexpr float EPS = 1e-6f;
constexpr int NPH = 27;
constexpr size_t O_Y = 0, O_NK = 25165824, O_NV = 58720256, O_SF = 92274688, O_SB = 125829120, O_END = 159383552;
constexpr size_t MiB = 1u << 20;
constexpr size_t WS_CTL = 0, CTL_BYTES = 1 * MiB;
constexpr size_t WS_MOD = 1 * MiB, WS_DECAY = 2 * MiB, WS_ZA = 4 * MiB, WS_T512 = 6 * MiB, WS_T256 = 7 * MiB, WS_T2048 = 8 * MiB;
constexpr size_t WS_WIN = 24 * MiB, WS_WBR = 105 * MiB, WS_WOUT = 129 * MiB, WS_WUP = 137 * MiB, WS_WDOWN = 181 * MiB;
constexpr size_t WS_H = 203 * MiB, WS_ZQ = 251 * MiB, WS_ZK = 275 * MiB, WS_ZVT = 299 * MiB, WS_ZG = 347 * MiB, WS_DQ = 395 * MiB, WS_DK = 443 * MiB, WS_DV = 493 * MiB;
constexpr size_t WS_ZF = 543 * MiB, WS_GATE = 591 * MiB, WS_QIN = 735 * MiB, WS_KENDT = 783 * MiB, WS_Y = 831 * MiB, WS_OINTRA = 927 * MiB, WS_OPART = 975 * MiB;
constexpr size_t WS_OF = 1071 * MiB, WS_OB = 1119 * MiB, WS_OFNET = 1167 * MiB, WS_SG = 1215 * MiB, WS_SV = 1224 * MiB, WS_XB2 = 1230 * MiB  , WS_END = 1278 * MiB;
constexpr size_t WS_MERGED = WS_H, WS_AGLA = WS_ZQ, WS_ADIFF = WS_ZF, WS_P = WS_DQ  , WS_YOUT = WS_Y, WS_U = WS_OINTRA, WS_ACT = WS_GATE, WS_X1B = WS_OF  , WS_UPQ = WS_OPART  , WS_ZAP = WS_OPART  ;
constexpr int CW_BAR = 4096;
constexpr int CW_Q = 1024;
constexpr int CW_ERR = 2048;

__device__ __forceinline__ float bf2f(bf16_t b) { return __uint_as_float(((unsigned)b) << 16); }
typedef __bf16 bf16x2_t __attribute__((ext_vector_type(2)));
__device__ __forceinline__ unsigned pk2(float lo, float hi) { const f32x2 v = {lo, hi}; const bf16x2_t b = __builtin_convertvector(v, bf16x2_t); return __builtin_bit_cast(unsigned, b); }
__device__ __forceinline__ unsigned f2bf(float f) { return pk2(f, 0.f) & 0xffffu; }
__device__ __forceinline__ float lo16(unsigned w) { return __uint_as_float(w << 16); }
__device__ __forceinline__ float hi16(unsigned w) { return __uint_as_float(w & 0xffff0000u); }
__device__ __forceinline__ unsigned cvt_pk_bf16(float lo, float hi) { unsigned r; asm volatile("v_cvt_pk_bf16_f32 %0, %1, %2" : "=v"(r) : "v"(lo), "v"(hi)); return r; }
__device__ __forceinline__ float shx(float v, int mask, int lane) { return __int_as_float(__builtin_amdgcn_ds_bpermute((lane ^ mask) << 2, __float_as_int(v))); }
__device__ __forceinline__ float wave_sum(float v, int lane) {
#pragma unroll
    for (int o = 1; o < 64; o <<= 1) v += shx(v, o, lane);
    return v;
}
__device__ __forceinline__ int ltid(int wave) { unsigned z = 0u; asm volatile("" : "+s"(z));
    int t = (wave << 6) | (int)__builtin_amdgcn_mbcnt_hi(~0u, __builtin_amdgcn_mbcnt_lo(~0u, z)); asm volatile("" : "+v"(t)); return t; }
__device__ __forceinline__ float sigmoid_f(float x) { return __builtin_amdgcn_rcpf(1.0f + __builtin_amdgcn_exp2f(-1.4426950408889634f * x)); }
__device__ __forceinline__ float silu_f(float x) { return x * sigmoid_f(x); }
__device__ __forceinline__ float logsig_f(float x) { return fminf(x, 0.0f) - 0.6931471805599453f * __builtin_amdgcn_logf(1.0f + __builtin_amdgcn_exp2f(-1.4426950408889634f * fabsf(x))); }
__device__ __forceinline__ float gelu_tanh_f(float x) { const float u2 = 1.5957691216057308f * (x + 0.044715f * x * x * x); return x * sigmoid_f(u2); }
__device__ __forceinline__ void unpack8(const u32x4 w, float (&f)[8]) { f[0] = lo16(w.x); f[1] = hi16(w.x); f[2] = lo16(w.y); f[3] = hi16(w.y); f[4] = lo16(w.z); f[5] = hi16(w.z); f[6] = lo16(w.w); f[7] = hi16(w.w); }
__device__ __forceinline__ u32x4 pack8(const float (&f)[8]) { u32x4 w; w.x = pk2(f[0], f[1]); w.y = pk2(f[2], f[3]); w.z = pk2(f[4], f[5]); w.w = pk2(f[6], f[7]); return w; }

namespace pg8 {
#define PG8_LAS __attribute__((address_space(3)))
constexpr int BM = 256, BK = 64, HALF = 128, HTB = HALF * BK * 2, STAGE_BYTES = 8 * HTB, NXCD = 8, WGM = 4;
__device__ __forceinline__ int lds_byte(int r, int c) { const int st = (r >> 4) * 2 + (c >> 5), rr = r & 15, cc = c & 31, ob = rr * 64 + cc * 2; return st * 1024 + (ob ^ (((ob >> 9) & 1) << 5)); }
__device__ __forceinline__ void stage_rc(int b, int& Rr, int& C) { const int st = b / 1024, sb = b % 1024, swz = sb ^ (((sb >> 9) & 1) << 5); Rr = (st >> 1) * 16 + swz / 64; C = (st & 1) * 32 + (swz % 64) / 2; }
__device__ __forceinline__ int perm32(int rho) { const int n = rho >> 4, i = rho & 15; return 8 * (i >> 2) + 4 * n + (i & 3); }
struct Unit { const char* a; const char* b; int pm, pn, z, nt; };
struct Gemm { int lda, ldb, K; };
__device__ __forceinline__ void tile_order(int L, int nM, int nN, int& pm, int& pn) {
    const int nwg = nM * nN; int wgid = L;
    { const int q = nwg / NXCD, r = nwg % NXCD, xcd = wgid % NXCD, off = wgid / NXCD; wgid = (xcd < r ? xcd * (q + 1) : r * (q + 1) + (xcd - r) * q) + off; }
    const int nig = WGM * nN, gid = wgid / nig, fm = gid * WGM, gsz = (nM - fm) < WGM ? (nM - fm) : WGM;
    pm = fm + ((wgid % nig) % gsz); pn = (wgid % nig) / gsz;
}
typedef f32x4 Acc[2][2][4][2];

template <class Epi, class Sched, bool ALIGN_EPI = false, bool SP2 = false>
__device__ __forceinline__ void gemm_phase(PG8_LAS unsigned char* lds, const Gemm g, const Sched& S, const Epi& E, int wave0) {
    const int tid = ltid(wave0), wid = __builtin_amdgcn_readfirstlane(tid >> 6), lane = tid & 63, wr = wid >> 2, wc = wid & 3, fr = lane & 15, fq = lane >> 4;
    const int K = g.K, nt = K / BK;
    unsigned voffA[2], voffB[2];
#pragma unroll
    for (int i = 0; i < 2; ++i) { int Rr, C; stage_rc(tid * 16 + i * 8192, Rr, C); const int Rb = Epi::PERM ? ((Rr & ~31) + perm32(Rr & 31)) : Rr;
        voffA[i] = (unsigned)(Rr * g.lda + C) * 2u; voffB[i] = (unsigned)(Rb * g.ldb + C) * 2u; }
    const size_t kstep = (size_t)(BK * 2);
    const size_t hstepA = (size_t)HALF * g.lda * 2, hstepB = (size_t)HALF * g.ldb * 2;
    const unsigned ldsw = (unsigned)wid * 1024u;
    const int aoff = lds_byte(wr * 64 + fr, fq * 8), boff = lds_byte(wc * 32 + fr, fq * 8);
#define PG8_SA(b, h) (((b) * 2 + (h)) * HTB)
#define PG8_SB(b, h) ((4 + (b) * 2 + (h)) * HTB)
#define PG8_STAGE(bufoff, gbase, voff) do { _Pragma("unroll") for (int _i = 0; _i < 2; ++_i) \
        __builtin_amdgcn_global_load_lds((const unsigned*)((const char*)(gbase) + (voff)[_i]), (PG8_LAS unsigned*)(lds + (bufoff) + ldsw + _i * 8192), 16, 0, 0); } while (0)
#define PG8_LDA(dst, b, h) do { _Pragma("unroll") for (int m = 0; m < 4; ++m) _Pragma("unroll") for (int k = 0; k < 2; ++k) dst[m][k] = *(const PG8_LAS bf16x8*)(lds + PG8_SA(b, h) + aoff + m * 2048 + k * 1024); } while (0)
#define PG8_LDB(dst, b, h) do { _Pragma("unroll") for (int n = 0; n < 2; ++n) _Pragma("unroll") for (int k = 0; k < 2; ++k) dst[n][k] = *(const PG8_LAS bf16x8*)(lds + PG8_SB(b, h) + boff + n * 2048 + k * 1024); } while (0)
#define PG8_MMA(ai, bj, At, Bt) do { __builtin_amdgcn_s_setprio(1); _Pragma("unroll") for (int m = 0; m < 4; ++m) _Pragma("unroll") for (int n = 0; n < 2; ++n) _Pragma("unroll") for (int k = 0; k < 2; ++k) \
        acc[ai][bj][m][n] = __builtin_amdgcn_mfma_f32_16x16x32_bf16(Bt[n][k], At[m][k], acc[ai][bj][m][n], 0, 0, 0); __builtin_amdgcn_s_setprio(0); } while (0)
#define PG8_WAIT_V(n) asm volatile("s_waitcnt vmcnt(" #n ")" ::: "memory")
#define PG8_WAIT_L(n) asm volatile("s_waitcnt lgkmcnt(" #n ")" ::: "memory")
#define PG8_BAR __builtin_amdgcn_s_barrier()
#define PG8_SCHED __builtin_amdgcn_sched_barrier(0)
    Unit cur, nxt; int ui = 0;
    cur.nt = 0;
    if (!S.next(0, cur)) return;
    f32x4 acc[2][2][4][2];
#pragma unroll
    for (int a = 0; a < 2; ++a)
#pragma unroll
        for (int b = 0; b < 2; ++b)
#pragma unroll
            for (int m = 0; m < 4; ++m)
#pragma unroll
                for (int n = 0; n < 2; ++n) acc[a][b][m][n] = (f32x4){0.f, 0.f, 0.f, 0.f};
    bf16x8 At[4][2], B0[2][2], B1[2][2];
    const char* cA = cur.a; const char* cB = cur.b;
    if constexpr (SP2) {
        PG8_STAGE(PG8_SB(0, 0), cB, voffB); PG8_STAGE(PG8_SB(0, 1), cB + hstepB, voffB); PG8_STAGE(PG8_SA(0, 0), cA, voffA); PG8_STAGE(PG8_SA(0, 1), cA + hstepA, voffA);
        if (wr == 1) PG8_BAR;
        PG8_WAIT_V(2); PG8_BAR;
        PG8_STAGE(PG8_SB(1, 0), cB + kstep, voffB); PG8_STAGE(PG8_SA(1, 0), cA + kstep, voffA); PG8_STAGE(PG8_SB(1, 1), cB + hstepB + kstep, voffB);
        PG8_WAIT_V(6); PG8_BAR;
    } else {
        PG8_STAGE(PG8_SB(0, 0), cB, voffB); PG8_STAGE(PG8_SA(0, 0), cA, voffA); PG8_STAGE(PG8_SB(0, 1), cB + hstepB, voffB); PG8_STAGE(PG8_SA(0, 1), cA + hstepA, voffA);
        if (wr == 1) PG8_BAR;
        PG8_WAIT_V(4); PG8_BAR;
        PG8_STAGE(PG8_SB(1, 0), cB + kstep, voffB); PG8_STAGE(PG8_SA(1, 0), cA + kstep, voffA); PG8_STAGE(PG8_SB(1, 1), cB + hstepB + kstep, voffB);
        PG8_WAIT_V(6); PG8_BAR;
    }
    for (;;) {
        nxt.nt = 0; const bool has_next = S.next(ui + 1, nxt);
        const int ntc = cur.nt ? cur.nt : nt;
        const char* nA = has_next ? nxt.a : cA; const char* nB = has_next ? nxt.b : cB;
        for (int t = 0; t < ntc; t += 2) {
            const bool last = (t == ntc - 2);
            const char* a1 = cA + (size_t)(t + 1) * kstep;
            const char* a2 = last ? nA : cA + (size_t)(t + 2) * kstep; const char* b2 = last ? nB : cB + (size_t)(t + 2) * kstep;
            const char* a3 = a2 + kstep; const char* b3 = b2 + kstep;
            if constexpr (SP2) {
            PG8_LDB(B0, 0, 0); PG8_LDB(B1, 0, 1); PG8_SCHED; PG8_LDA(At, 0, 0); PG8_STAGE(PG8_SA(1, 1), a1 + hstepA, voffA);
            PG8_WAIT_V(8); PG8_WAIT_L(0); PG8_BAR; PG8_MMA(0, 0, At, B0); PG8_MMA(0, 1, At, B1); PG8_BAR; PG8_SCHED;
            PG8_LDA(At, 0, 1); PG8_STAGE(PG8_SB(0, 0), b2, voffB); PG8_STAGE(PG8_SB(0, 1), b2 + hstepB, voffB); PG8_STAGE(PG8_SA(0, 0), a2, voffA);
            PG8_WAIT_V(8); PG8_WAIT_L(0); PG8_BAR; PG8_MMA(1, 0, At, B0); PG8_MMA(1, 1, At, B1); PG8_BAR; PG8_SCHED;
            PG8_LDB(B0, 1, 0); PG8_LDB(B1, 1, 1); PG8_SCHED; PG8_LDA(At, 1, 0); PG8_STAGE(PG8_SA(0, 1), a2 + hstepA, voffA);
            PG8_WAIT_V(8); PG8_WAIT_L(0); PG8_BAR; PG8_MMA(0, 0, At, B0); PG8_MMA(0, 1, At, B1); PG8_BAR; PG8_SCHED;
            PG8_LDA(At, 1, 1); PG8_STAGE(PG8_SB(1, 0), b3, voffB); PG8_STAGE(PG8_SB(1, 1), b3 + hstepB, voffB); PG8_STAGE(PG8_SA(1, 0), a3, voffA);
            PG8_WAIT_V(8); PG8_WAIT_L(0); PG8_BAR; PG8_MMA(1, 0, At, B0); PG8_MMA(1, 1, At, B1); PG8_BAR; PG8_SCHED;
            } else {
            PG8_LDB(B0, 0, 0); PG8_SCHED; PG8_LDA(At, 0, 0); PG8_STAGE(PG8_SA(1, 1), a1 + hstepA, voffA);
            PG8_WAIT_L(8); PG8_BAR; PG8_WAIT_L(0); PG8_MMA(0, 0, At, B0); PG8_BAR; PG8_SCHED;
            PG8_LDB(B1, 0, 1); PG8_STAGE(PG8_SB(0, 0), b2, voffB);
            PG8_BAR; PG8_WAIT_L(0); PG8_MMA(0, 1, At, B1); PG8_BAR;
            PG8_LDA(At, 0, 1); PG8_STAGE(PG8_SA(0, 0), a2, voffA);
            PG8_BAR; PG8_WAIT_L(0); PG8_MMA(1, 0, At, B0); PG8_BAR; PG8_SCHED;
            PG8_STAGE(PG8_SB(0, 1), b2 + hstepB, voffB);
            PG8_WAIT_V(6); PG8_BAR; PG8_MMA(1, 1, At, B1); PG8_BAR;
            PG8_LDB(B0, 1, 0); PG8_SCHED; PG8_LDA(At, 1, 0); PG8_STAGE(PG8_SA(0, 1), a2 + hstepA, voffA);
            PG8_WAIT_L(8); PG8_BAR; PG8_WAIT_L(0); PG8_MMA(0, 0, At, B0); PG8_BAR; PG8_SCHED;
            PG8_LDB(B1, 1, 1); PG8_STAGE(PG8_SB(1, 0), b3, voffB);
            PG8_BAR; PG8_WAIT_L(0); PG8_MMA(0, 1, At, B1); PG8_BAR;
            PG8_LDA(At, 1, 1); PG8_STAGE(PG8_SA(1, 0), a3, voffA);
            PG8_BAR; PG8_WAIT_L(0); PG8_MMA(1, 0, At, B0); PG8_BAR; PG8_SCHED;
            PG8_STAGE(PG8_SB(1, 1), b3 + hstepB, voffB);
            PG8_WAIT_V(6); PG8_BAR; PG8_MMA(1, 1, At, B1); PG8_BAR;
            }
        }
        if constexpr (ALIGN_EPI) { if (wr == 0) PG8_BAR; }
        E(acc, cur, wr, wc, fr, fq);
        if (!has_next) break;
#pragma unroll
        for (int a = 0; a < 2; ++a)
#pragma unroll
            for (int b = 0; b < 2; ++b)
#pragma unroll
                for (int m = 0; m < 4; ++m)
#pragma unroll
                    for (int n = 0; n < 2; ++n) acc[a][b][m][n] = (f32x4){0.f, 0.f, 0.f, 0.f};
        cur = nxt; cA = nA; cB = nB; ++ui;
        if constexpr (ALIGN_EPI) { if (wr == 1) PG8_BAR; }
    }
    PG8_WAIT_V(0);
    if constexpr (!ALIGN_EPI) { if (wr == 0) PG8_BAR; }
    PG8_BAR;
#undef PG8_SA
#undef PG8_SB
#undef PG8_STAGE
#undef PG8_LDA
#undef PG8_LDB
#undef PG8_MMA
#undef PG8_WAIT_V
#undef PG8_WAIT_L
#undef PG8_BAR
#undef PG8_SCHED
}

__device__ __forceinline__ u32x4 pack_acc(const f32x4 v0, const f32x4 v1) { u32x4 w; w.x = cvt_pk_bf16(v0[0], v0[1]); w.y = cvt_pk_bf16(v0[2], v0[3]); w.z = cvt_pk_bf16(v1[0], v1[1]); w.w = cvt_pk_bf16(v1[2], v1[3]); return w; }

struct EpiBf16 {
    static constexpr bool PERM = true;
    bf16_t* O; int ld; bf16_t* O2 = nullptr; int rowsub = 0;
    __device__ __forceinline__ void operator()(const Acc& acc, const Unit& u, int wr, int wc, int fr, int fq) const {
        bf16_t* base = (u.z ? O2 - (size_t)rowsub * ld : O) + (size_t)(u.pm * BM + wr * 64 + fr) * ld + u.pn * BM + wc * 32 + 8 * fq;
#pragma unroll
        for (int ai = 0; ai < 2; ++ai)
#pragma unroll
            for (int m = 0; m < 4; ++m) { bf16_t* rowp = base + (size_t)(ai * HALF + m * 16) * ld;
#pragma unroll
                for (int bj = 0; bj < 2; ++bj) *(u32x4*)(rowp + bj * HALF) = pack_acc(acc[ai][bj][m][0], acc[ai][bj][m][1]); }
    }
};
struct EpiF32 {
    static constexpr bool PERM = false;
    float* C; int ld;
    __device__ __forceinline__ void operator()(const Acc& acc, const Unit& u, int wr, int wc, int fr, int fq) const {
        float* base = C + (size_t)(u.pm * BM + wr * 64 + fr) * ld + u.pn * BM + wc * 32 + 4 * fq;
#pragma unroll
        for (int ai = 0; ai < 2; ++ai)
#pragma unroll
            for (int m = 0; m < 4; ++m) { float* rowp = base + (size_t)(ai * HALF + m * 16) * ld;
#pragma unroll
                for (int bj = 0; bj < 2; ++bj)
#pragma unroll
                    for (int n = 0; n < 2; ++n) *(f32x4*)(rowp + bj * HALF + n * 16) = acc[ai][bj][m][n]; }
    }
};
struct EpiBf16z {
    static constexpr bool PERM = true;
    unsigned char* ws;
    __device__ __forceinline__ void operator()(const Acc& acc, const Unit& u, int wr, int wc, int fr, int fq) const {
        bf16_t* base = (bf16_t*)(ws + (u.z ? WS_OINTRA : WS_YOUT)) + (size_t)(u.pm * BM + wr * 64 + fr) * 2048 + u.pn * BM + wc * 32 + 8 * fq;
#pragma unroll
        for (int ai = 0; ai < 2; ++ai)
#pragma unroll
            for (int m = 0; m < 4; ++m) { bf16_t* rowp = base + (size_t)(ai * HALF + m * 16) * 2048;
#pragma unroll
                for (int bj = 0; bj < 2; ++bj) *(u32x4*)(rowp + bj * HALF) = pack_acc(acc[ai][bj][m][0], acc[ai][bj][m][1]); }
    }
};
__device__ __forceinline__ float dpp_ror1(float x) { return __int_as_float(__builtin_amdgcn_update_dpp(0, __float_as_int(x), 0x121, 0xf, 0xf, false)); }
__device__ __forceinline__ float dpp_rol1(float x) { return __int_as_float(__builtin_amdgcn_update_dpp(0, __float_as_int(x), 0x12f, 0xf, 0xf, false)); }
struct EpiFfn {
    static constexpr bool PERM = true, CARRY = false;
    bf16_t* act; bf16_t* sg; bf16_t* sv; const float* cw; const float* cb; bf16_t* upq;
    __device__ __forceinline__ void operator()(const Acc& acc, const Unit& u, int wr, int wc, int fr, int fq) const {
        if (u.z) {
            bf16_t* base = upq + (size_t)(u.pm * BM + wr * 64 + fr) * 256 + wc * 32 + 8 * fq;
#pragma unroll
            for (int ai = 0; ai < 2; ++ai)
#pragma unroll
                for (int m = 0; m < 4; ++m) { bf16_t* rowp = base + (size_t)(ai * HALF + m * 16) * 256;
#pragma unroll
                    for (int bj = 0; bj < 2; ++bj) *(u32x4*)(rowp + bj * HALF) = pack_acc(acc[ai][bj][m][0], acc[ai][bj][m][1]); }
            return;
        }
        const int chb = u.pn * 128 + wc * 32 + 8 * fq;
        float w0[8], w1[8], w2[8], bb[8];
#pragma unroll
        for (int c = 0; c < 8; ++c) { w0[c] = cw[chb + c]; w1[c] = cw[DFF + chb + c]; w2[c] = cw[2 * DFF + chb + c]; bb[c] = cb[chb + c]; }
        const bool f0 = fr == 0, f15 = fr == 15;
#pragma unroll
        for (int ai = 0; ai < 2; ++ai) {
            const int rowb = u.pm * BM + ai * HALF + wr * 64;
#pragma unroll
            for (int m = 0; m < 4; ++m) { float o[8];
#pragma unroll
                for (int c = 0; c < 8; ++c) { const int n = c >> 2, j = c & 3; const float g = acc[ai][1][m][n][j];
                    const float sendp = f15 ? (m > 0 ? acc[ai][1][m > 0 ? m - 1 : 0][n][j] : 0.f) : g, sendn = f0 ? (m < 3 ? acc[ai][1][m < 3 ? m + 1 : 3][n][j] : 0.f) : g;
                    const float prev = dpp_ror1(sendp), next = dpp_rol1(sendn);
                    const float gt = w0[c] * prev + w1[c] * g + w2[c] * next + bb[c]; o[c] = gelu_tanh_f(gt) * acc[ai][0][m][n][j]; }
                const bool bnd = (m == 0 && f0) || (m == 3 && f15);
                if (!bnd) *(u32x4*)(act + (size_t)(rowb + 16 * m + fr) * DFF + chb) = pack8(o); }
            const int span = rowb >> 6;
            if (fr < 2) { *(u32x4*)(sg + (size_t)(span * 4 + fr) * DFF + chb) = pack_acc(acc[ai][1][0][0], acc[ai][1][0][1]); if (f0) *(u32x4*)(sv + (size_t)(span * 2) * DFF + chb) = pack_acc(acc[ai][0][0][0], acc[ai][0][0][1]); }
            if (fr >= 14) { *(u32x4*)(sg + (size_t)(span * 4 + fr - 12) * DFF + chb) = pack_acc(acc[ai][1][3][0], acc[ai][1][3][1]); if (f15) *(u32x4*)(sv + (size_t)(span * 2 + 1) * DFF + chb) = pack_acc(acc[ai][0][3][0], acc[ai][0][3][1]); }
        }
    }
};
struct EpiIn {
    static constexpr bool PERM = true;
    unsigned char* ws; float* out; int layer;
    __device__ __forceinline__ void operator()(const Acc& acc, const Unit& u, int wr, int wc, int fr, int fq) const {
        const int pm = u.pm, pn = u.pn;
        if (u.z == 1) {
            bf16_t* base = (bf16_t*)(ws + WS_ZVT) + (size_t)(pm * BM + wr * 64 + fr) * R + pn * BM + wc * 32 + 8 * fq;
#pragma unroll
            for (int ai = 0; ai < 2; ++ai)
#pragma unroll
                for (int m = 0; m < 4; ++m) { bf16_t* rowp = base + (size_t)(ai * HALF + m * 16) * R;
#pragma unroll
                    for (int bj = 0; bj < 2; ++bj) *(u32x4*)(rowp + bj * HALF) = pack_acc(acc[ai][bj][m][0], acc[ai][bj][m][1]); }
            return;
        }
        if (u.z >= 2) {
            if (wc == 0) {
                float* p0 = (float*)(ws + WS_ZAP) + (size_t)(u.z - 2) * R * 32 + (size_t)(pm * BM + wr * 64 + fr) * 32 + 8 * fq;
#pragma unroll
                for (int ai = 0; ai < 2; ++ai)
#pragma unroll
                    for (int m = 0; m < 4; ++m) { float* p = p0 + (size_t)(ai * HALF + m * 16) * 32;
                        *(f32x4*)p = acc[ai][0][m][0]; *(f32x4*)(p + 4) = acc[ai][0][m][1]; }
            }
            return;
        }
        size_t boff; int ld, c0, rowadd = 0; bool f32o = false, act = false;
        if (pn < 4) { boff = WS_ZQ; ld = 1024; c0 = pn * 256; }
        else if (pn < 8) { boff = WS_ZK; ld = 1024; c0 = (pn - 4) * 256; }
        else if (pn < 16) { boff = WS_ZG; ld = 2048; c0 = (pn - 8) * 256; }
        else if (pn < 24) { boff = WS_DQ; ld = 2048; c0 = (pn - 16) * 256; }
        else if (pn < 40) { const bool isv = pn >= 32; boff = isv ? WS_DV : WS_DK; ld = 2048; c0 = (pn - (isv ? 32 : 24)) * 256;
            if (pm >= 32) rowadd = 256 * (((pm - 32) >> 3) + 1); else f32o = true; }
        else if (pn < 48) { const int cc = (pn - 40) * 256; boff = WS_ZF + (size_t)(cc >> 9) * R * 512 * 2; ld = 512; c0 = cc & 511; }
        else { boff = WS_GATE; ld = 6144; c0 = (pn - 48) * 256; act = true; }
        const int rin0 = wr * 64 + fr, cin = wc * 32 + 8 * fq;
        bf16_t* base = (bf16_t*)(ws + boff) + (size_t)(pm * BM + rowadd + rin0) * ld + c0 + cin;
#pragma unroll
        for (int ai = 0; ai < 2; ++ai)
#pragma unroll
            for (int m = 0; m < 4; ++m) { bf16_t* rowp = base + (size_t)(ai * HALF + m * 16) * ld;
#pragma unroll
                for (int bj = 0; bj < 2; ++bj) { f32x4 v0 = acc[ai][bj][m][0], v1 = acc[ai][bj][m][1];
                    if (act) {
#pragma unroll
                        for (int j = 0; j < 4; ++j) { v0[j] = sigmoid_f(v0[j]); v1[j] = sigmoid_f(v1[j]); } }
                    *(u32x4*)(rowp + bj * HALF) = pack_acc(v0, v1); } }
        if (f32o) {
            float* fb = out + (pn >= 32 ? O_NV : O_NK) + ((size_t)(pm * 2 + layer) * 256 + rin0) * 2048 + c0 + cin;
#pragma unroll
            for (int ai = 0; ai < 2; ++ai)
#pragma unroll
                for (int m = 0; m < 4; ++m) { float* fp = fb + (size_t)(ai * HALF + m * 16) * 2048;
#pragma unroll
                    for (int bj = 0; bj < 2; ++bj) { __builtin_nontemporal_store(acc[ai][bj][m][0], (f32x4*)(fp + bj * HALF)); __builtin_nontemporal_store(acc[ai][bj][m][1], (f32x4*)(fp + bj * HALF + 4)); } }
        }
    }
};
struct EpiBr {
    static constexpr bool PERM = true, CARRY = false;
    unsigned char* pbase; const bf16_t* gate;
    __device__ __forceinline__ void operator()(const Acc& acc, const Unit& u, int wr, int wc, int fr, int fq) const {
        const int zb = u.z & 3, kh = u.z >> 2;
        bf16_t* P = kh ? (bf16_t*)(pbase - WS_DQ + WS_QIN) - (size_t)RC * 2048 : (bf16_t*)(pbase + (zb == 0 ? (size_t)0 : (zb == 1 ? (WS_DK - WS_DQ) : (WS_DV - WS_DQ))));
        const int row0 = u.pm * BM + wr * 64 + fr, col0 = u.pn * BM + wc * 32 + 8 * fq;
        u32x4 gw[2][4][2];
#pragma unroll
        for (int ai = 0; ai < 2; ++ai)
#pragma unroll
            for (int m = 0; m < 4; ++m)
#pragma unroll
                for (int bj = 0; bj < 2; ++bj) gw[ai][m][bj] = *(const u32x4*)(gate + (size_t)(row0 + ai * HALF + m * 16) * 6144 + zb * 2048 + col0 + bj * HALF);
#pragma unroll
        for (int ai = 0; ai < 2; ++ai)
#pragma unroll
            for (int m = 0; m < 4; ++m) { const int row = row0 + ai * HALF + m * 16;
#pragma unroll
                for (int bj = 0; bj < 2; ++bj) { const int col = col0 + bj * HALF;
                    float gv[8]; unpack8(gw[ai][m][bj], gv);
                    f32x4 v0 = acc[ai][bj][m][0], v1 = acc[ai][bj][m][1];
#pragma unroll
                    for (int j = 0; j < 4; ++j) { v0[j] *= gv[j]; v1[j] *= gv[4 + j]; }
                    *(u32x4*)(P + (size_t)row * 2048 + col) = pack_acc(v0, v1); } }
    }
};
struct EpiY {
    static constexpr bool PERM = true;
    bf16_t* Y;
    __device__ __forceinline__ void operator()(const Acc& acc, const Unit& u, int wr, int wc, int fr, int fq) const {
        const int cs = u.pm >> 1, ch0 = (u.pm & 1) * 256, g = u.z;
        size_t off;
        if (u.pn < 32) off = (size_t)u.pn * 512 + cs * 256; else { const int bb = (u.pn - 32) >> 3, lt = (u.pn - 32) & 7; off = 16384 + (size_t)bb * 4096 + cs * 2048 + lt * 256; }
        bf16_t* base = Y + (size_t)(g * 512 + ch0 + wr * 64 + fr) * 24576 + off + wc * 32 + 8 * fq;
#pragma unroll
        for (int ai = 0; ai < 2; ++ai)
#pragma unroll
            for (int m = 0; m < 4; ++m) { bf16_t* rowp = base + (size_t)(ai * HALF + m * 16) * 24576;
#pragma unroll
                for (int bj = 0; bj < 2; ++bj) *(u32x4*)(rowp + bj * HALF) = pack_acc(acc[ai][bj][m][0], acc[ai][bj][m][1]); }
    }
};
struct EpiZaQ {
    static constexpr bool PERM = true;
    unsigned char* ws;
    __device__ __forceinline__ void operator()(const Acc& acc, const Unit& u, int wr, int wc, int fr, int fq) const {
        if (wc != 0) return;
        float* p0 = (float*)(ws + WS_ZAP) + (size_t)u.z * R * 32 + (size_t)(u.pm * BM + wr * 64 + fr) * 32 + 8 * fq;
#pragma unroll
        for (int ai = 0; ai < 2; ++ai)
#pragma unroll
            for (int m = 0; m < 4; ++m) { float* p = p0 + (size_t)(ai * HALF + m * 16) * 32;
                *(f32x4*)p = acc[ai][0][m][0]; *(f32x4*)(p + 4) = acc[ai][0][m][1]; }
    }
};
}

namespace attn {
constexpr int DH = 128, NW = 8, QBLK = 32, KVBLK = 64;
constexpr float SCALE = 0.088388347648318440f;
constexpr float THR = 8.f;
constexpr size_t SHM_V = KVBLK * DH * 2, SHM_K = KVBLK * DH * 2, SHM_ATTN = 2 * SHM_V + 2 * SHM_K + NW * 64 * 4;
#define KSWZ(row, colB) ((row) * 256 + ((colB) ^ (((row) & 7) << 4)))
#define SBAR() __builtin_amdgcn_sched_barrier(0)
__device__ __forceinline__ int crow(int r, int hi) { return (r & 3) + 8 * (r >> 2) + 4 * hi; }
__device__ __forceinline__ unsigned cvtpk(float lo, float hi) { unsigned r; asm volatile("v_cvt_pk_bf16_f32 %0, %1, %2" : "=v"(r) : "v"(lo), "v"(hi)); return r; }
__device__ __forceinline__ void partialSM(f32x16& p0, f32x16& p1, float& m_reg, float& mn, float& alpha) {
  constexpr float C = SCALE * 1.4426950408889634f;
  float pmax = p0[0];
#pragma unroll
  for (int r = 1; r < 16; ++r) pmax = fmaxf(pmax, p0[r]);
#pragma unroll
  for (int r = 0; r < 16; ++r) pmax = fmaxf(pmax, p1[r]);
  { auto rr = __builtin_amdgcn_permlane32_swap(__float_as_uint(pmax), __float_as_uint(pmax), false, false);
    pmax = fmaxf(__uint_as_float(rr[0]), __uint_as_float(rr[1])); }
  if (__builtin_expect(__all(pmax - m_reg <= THR / SCALE), 1)) { mn = m_reg; alpha = 1.f; }
  else { mn = fmaxf(m_reg, pmax); alpha = __builtin_amdgcn_exp2f((m_reg - mn) * C); m_reg = mn; }
  float mnC = -mn * C;
#pragma unroll
  for (int r = 0; r < 16; ++r) p0[r] = fmaf(p0[r], C, mnC);
#pragma unroll
  for (int r = 0; r < 16; ++r) p1[r] = fmaf(p1[r], C, mnC);
#pragma unroll
  for (int r = 0; r < 16; ++r) p0[r] = __builtin_amdgcn_exp2f(p0[r]);
}
__device__ __forceinline__ void finishSM(f32x16& p0, f32x16& p1, float alpha, float& l_reg, bf16x8& pa0, bf16x8& pa1, bf16x8& pa2, bf16x8& pa3) {
#pragma unroll
  for (int r = 0; r < 16; ++r) p1[r] = __builtin_amdgcn_exp2f(p1[r]);
  float ps = 0;
#pragma unroll
  for (int r = 0; r < 16; ++r) ps += p0[r];
#pragma unroll
  for (int r = 0; r < 16; ++r) ps += p1[r];
  { auto rr = __builtin_amdgcn_permlane32_swap(__float_as_uint(ps), __float_as_uint(ps), false, false);
    ps = __uint_as_float(rr[0]) + __uint_as_float(rr[1]); }
  l_reg = l_reg * alpha + ps;
#define PK4(P, BASE, OUT) do { unsigned a0 = cvtpk(P[BASE + 0], P[BASE + 1]), a1 = cvtpk(P[BASE + 2], P[BASE + 3]);   \
    unsigned b0 = cvtpk(P[BASE + 4], P[BASE + 5]), b1 = cvtpk(P[BASE + 6], P[BASE + 7]);                              \
    auto r0 = __builtin_amdgcn_permlane32_swap(a0, b0, false, false); auto r1 = __builtin_amdgcn_permlane32_swap(a1, b1, false, false); \
    u32x4 w = {r0[0], r1[0], r0[1], r1[1]}; OUT = *reinterpret_cast<bf16x8*>(&w); } while (0)
  PK4(p0, 0, pa0); PK4(p0, 8, pa1); PK4(p1, 0, pa2); PK4(p1, 8, pa3);
#undef PK4
}
__device__ __forceinline__ void qkt(f32x16& p0, f32x16& p1, const bf16_t* Ks, const bf16x8* qr, int r32, int hi) {
  p0 = f32x16{}; p1 = f32x16{};
#pragma unroll
  for (int d0 = 0; d0 < 8; ++d0) { int cb = (d0 * 16 + hi * 8) * 2;
    bf16x8 b0 = *reinterpret_cast<const bf16x8*>((const char*)Ks + KSWZ(r32, cb));
    bf16x8 b1 = *reinterpret_cast<const bf16x8*>((const char*)Ks + KSWZ(32 + r32, cb));
    p0 = __builtin_amdgcn_mfma_f32_32x32x16_bf16(b0, qr[d0], p0, 0, 0, 0);
    p1 = __builtin_amdgcn_mfma_f32_32x32x16_bf16(b1, qr[d0], p1, 0, 0, 0); }
}
__device__ __forceinline__ int v_st(int k, int c) { const int kk = (k & ~0xC) | ((k & 4) << 1) | ((k & 8) >> 1); return ((kk >> 3) * 4 + (c >> 5)) * 512 + ((kk & 7) * 32 + (c & 31)) * 2; }
__device__ __forceinline__ int v_rd_base(int lane) { return ((lane & 3) << 3) | (((lane >> 2) & 3) << 6) | (((lane >> 4) & 1) << 5) | (((lane >> 5) & 1) << 8); }
constexpr int v_rd_off(int d0, int ks, int half) { return d0 * 512 + ks * 4096 + half * 2048; }
template <int OFF> __device__ __forceinline__ s16x4 tr_read(int vb) {
  s16x4 r; asm volatile("ds_read_b64_tr_b16 %0, %1 offset:%2" : "=&v"(r) : "v"(vb), "i"(OFF) : "memory"); return r;
}
template <int D0> __device__ __forceinline__ void pv_one(f32x16& od, int vb, bf16x8 pa0, bf16x8 pa1, bf16x8 pa2, bf16x8 pa3) {
  const s16x4 l0 = tr_read<v_rd_off(D0, 0, 0)>(vb), h0 = tr_read<v_rd_off(D0, 0, 1)>(vb), l1 = tr_read<v_rd_off(D0, 1, 0)>(vb), h1 = tr_read<v_rd_off(D0, 1, 1)>(vb);
  const s16x4 l2 = tr_read<v_rd_off(D0, 2, 0)>(vb), h2 = tr_read<v_rd_off(D0, 2, 1)>(vb), l3 = tr_read<v_rd_off(D0, 3, 0)>(vb), h3 = tr_read<v_rd_off(D0, 3, 1)>(vb);
  asm volatile("s_waitcnt lgkmcnt(0)" ::: "memory"); SBAR();
#define PK(L, H) (bf16x8){L[0], L[1], L[2], L[3], H[0], H[1], H[2], H[3]}
  od = __builtin_amdgcn_mfma_f32_32x32x16_bf16(pa0, PK(l0, h0), od, 0, 0, 0);
  od = __builtin_amdgcn_mfma_f32_32x32x16_bf16(pa1, PK(l1, h1), od, 0, 0, 0);
  od = __builtin_amdgcn_mfma_f32_32x32x16_bf16(pa2, PK(l2, h2), od, 0, 0, 0);
  od = __builtin_amdgcn_mfma_f32_32x32x16_bf16(pa3, PK(l3, h3), od, 0, 0, 0);
#undef PK
}
__device__ __forceinline__ void pv_d0(f32x16* o, int vb, bf16x8 pa0, bf16x8 pa1, bf16x8 pa2, bf16x8 pa3) {
  pv_one<0>(o[0], vb, pa0, pa1, pa2, pa3); pv_one<1>(o[1], vb, pa0, pa1, pa2, pa3); pv_one<2>(o[2], vb, pa0, pa1, pa2, pa3); pv_one<3>(o[3], vb, pa0, pa1, pa2, pa3);
}
template <int LDQ, int LDK, int LDO>
__device__ __forceinline__ void attn_dense_body(const bf16_t* __restrict__ Qb, const bf16_t* __restrict__ Kh, const bf16_t* __restrict__ Vh, bf16_t* __restrict__ Ob, int seq, char* lds, int wave0) {
  const int tid = ltid(wave0), wid = tid >> 6, lane = tid & 63, r32 = lane & 31, hi = lane >> 5;
  bf16_t* V_lds = (bf16_t*)lds; bf16_t* K_lds = (bf16_t*)(lds + 2 * SHM_V);
  float* ws = (float*)(lds + 2 * SHM_V + 2 * SHM_K) + wid * 64; float* li_l = ws; float* al_l = ws + 32;
  float m_reg = -1e30f, l_reg = 0; f32x16 o[4] = {}; bf16x8 qr[8];
  const bf16_t* Qw = Qb + (long)(wid * QBLK + r32) * LDQ + hi * 8;
#pragma unroll
  for (int d0 = 0; d0 < 8; ++d0) qr[d0] = *reinterpret_cast<const bf16x8*>(Qw + d0 * 16);
  const int sr = tid >> 4, sc = (tid & 15) * 8, vst0 = v_st(sr, sc), vst1 = v_st(32 + sr, sc);
  const int vb0 = (int)(uintptr_t)V_lds + v_rd_base(lane);
  struct { bf16x8 vs0, vs1, ks0, ks1; } sr_[2];
#define LD8(p) (*reinterpret_cast<const bf16x8*>(p))
#define SLOAD(i, k0) do { sr_[i].vs0 = LD8(&Vh[(long)((k0) + sr) * LDK + sc]); sr_[i].vs1 = LD8(&Vh[(long)((k0) + 32 + sr) * LDK + sc]); \
    sr_[i].ks0 = LD8(&Kh[(long)((k0) + sr) * LDK + sc]); sr_[i].ks1 = LD8(&Kh[(long)((k0) + 32 + sr) * LDK + sc]); } while (0)
#define SWRITE(b, i) do { *(bf16x8*)((char*)V_lds + (b) * SHM_V + vst0) = sr_[i].vs0;          \
    *(bf16x8*)((char*)V_lds + (b) * SHM_V + vst1) = sr_[i].vs1; int kc = sc * 2;               \
    *(bf16x8*)((char*)K_lds + (b) * SHM_K + KSWZ(sr, kc)) = sr_[i].ks0;                       \
    *(bf16x8*)((char*)K_lds + (b) * SHM_K + KSWZ(32 + sr, kc)) = sr_[i].ks1; } while (0)
#define SWAIT() asm volatile("s_waitcnt vmcnt(4)" ::: "memory")
#define RESC(a) do { if (__any((a) < 1.f)) { if (hi == 0) al_l[r32] = (a); asm volatile("s_waitcnt lgkmcnt(0)" ::: "memory"); \
    _Pragma("unroll") for (int d = 0; d < 4; ++d) _Pragma("unroll") for (int r = 0; r < 16; ++r) o[d][r] *= al_l[crow(r, hi)]; } } while (0)
  f32x16 pA0, pA1, pB0, pB1; float mnA, mnB, alA, alB; bf16x8 pa0, pa1, pa2, pa3; const int NT = seq / KVBLK;
  constexpr int SE = 0, SO = 1;
  SLOAD(SE, 0); asm volatile("s_waitcnt vmcnt(0)" ::: "memory"); SWRITE(0, SE); __syncthreads();
  qkt(pA0, pA1, K_lds, qr, r32, hi); partialSM(pA0, pA1, m_reg, mnA, alA);
  SLOAD(SO, KVBLK); if (2 < NT) SLOAD(SE, 2 * KVBLK);
  SWAIT(); SWRITE(1, SO); __syncthreads();
  for (int j = 1; j + 1 < NT; j += 2) {
    SBAR(); qkt(pB0, pB1, (bf16_t*)((char*)K_lds + SHM_K), qr, r32, hi);
    finishSM(pA0, pA1, alA, l_reg, pa0, pa1, pa2, pa3); SBAR();
    SLOAD(SO, (j + 2) * KVBLK); SBAR();
    pv_d0(o, vb0, pa0, pa1, pa2, pa3); partialSM(pB0, pB1, m_reg, mnB, alB);
    __syncthreads(); SWAIT(); SWRITE(0, SE);
    RESC(alB); __syncthreads();
    SBAR(); qkt(pA0, pA1, K_lds, qr, r32, hi);
    finishSM(pB0, pB1, alB, l_reg, pa0, pa1, pa2, pa3); SBAR();
    if (j + 3 < NT) SLOAD(SE, (j + 3) * KVBLK); SBAR();
    pv_d0(o, vb0 + (int)SHM_V, pa0, pa1, pa2, pa3); partialSM(pA0, pA1, m_reg, mnA, alA);
    __syncthreads(); SWAIT(); SWRITE(1, SO);
    RESC(alA); __syncthreads();
  }
  SBAR(); qkt(pB0, pB1, (bf16_t*)((char*)K_lds + SHM_K), qr, r32, hi);
  finishSM(pA0, pA1, alA, l_reg, pa0, pa1, pa2, pa3); SBAR();
  pv_d0(o, vb0, pa0, pa1, pa2, pa3); partialSM(pB0, pB1, m_reg, mnB, alB);
  __syncthreads(); RESC(alB);
  finishSM(pB0, pB1, alB, l_reg, pa0, pa1, pa2, pa3); SBAR();
  pv_d0(o, vb0 + (int)SHM_V, pa0, pa1, pa2, pa3);
  if (hi == 0) li_l[r32] = l_reg; asm volatile("s_waitcnt lgkmcnt(0)" ::: "memory");
  float rli[16];
#pragma unroll
  for (int r = 0; r < 16; ++r) rli[r] = __builtin_amdgcn_rcpf(li_l[crow(r, hi)]);
  bf16_t* Ow = Ob + (long)(wid * QBLK) * LDO;
#pragma unroll
  for (int r = 0; r < 16; ++r) { int orow = crow(r, hi);
#pragma unroll
    for (int d0 = 0; d0 < 4; ++d0) Ow[(long)orow * LDO + d0 * 32 + r32] = (bf16_t)f2bf(o[d0][r] * rli[r]); }
#undef LD8
#undef SLOAD
#undef SWRITE
#undef SWAIT
#undef RESC
}
}

#define XB_TMO      128
#define XB_XCNT(j)  (256  + 64 * (j))
#define XB_XSUB(j)  (1280 + 64 * (j))
#define XB_XGEN(j)  (2304 + 64 * (j))
#define XB_TOP      3328
#define XB_TOPGEN   3392
#define XCD_BAR_WORDS 3456
#define XB_SPIN_CAP (1u << 18)
__device__ __forceinline__ unsigned xb_ld(unsigned* p)              { return __hip_atomic_load(p, __ATOMIC_RELAXED, __HIP_MEMORY_SCOPE_AGENT); }
__device__ __forceinline__ unsigned xb_add(unsigned* p, unsigned v) { return __hip_atomic_fetch_add(p, v, __ATOMIC_RELAXED, __HIP_MEMORY_SCOPE_AGENT); }
__device__ __forceinline__ unsigned xb_xcc_id() { return (unsigned)__builtin_amdgcn_s_getreg((3 << 11) | 20) & 0xFu; }
#define XB_SPIN(cond, bar) do { unsigned _sp = 0; while (cond) { __builtin_amdgcn_s_sleep(1); \
    if ((++_sp & 255u) == 0u) { if (xb_ld(&(bar)[XB_TMO])) break; if (_sp > XB_SPIN_CAP) { atomicAdd(&(bar)[XB_TMO], 1u); break; } } } } while (0)
struct XcdBarrier { unsigned* bar; unsigned x; volatile LAS unsigned* st; };
__device__ __forceinline__ XcdBarrier xcd_barrier_post(unsigned* bar, volatile LAS unsigned* st) {
    XcdBarrier b; b.bar = bar; b.x = xb_xcc_id(); b.st = st;
    if (threadIdx.x == 0) (void)xb_add(&bar[XB_XCNT(b.x)], 1u);
    return b;
}
__device__ __forceinline__ void xcd_barrier_complete(unsigned* bar, unsigned x, unsigned& nloc, unsigned& nx) {
    const unsigned G = gridDim.x * gridDim.y * gridDim.z;
    unsigned sum, cnt, mine, sp = 0u;
    for (;;) {
        sum = 0u; cnt = 0u; mine = 0u;
#pragma unroll
        for (unsigned j = 0; j < 16; ++j) { const unsigned c = xb_ld(&bar[XB_XCNT(j)]); sum += c; cnt += (c > 0u) ? 1u : 0u; mine = (j == x) ? c : mine; }
        if (sum == G) break;
        __builtin_amdgcn_s_sleep(1);
        if ((++sp & 255u) == 0u) { if (xb_ld(&bar[XB_TMO])) break; if (sp > XB_SPIN_CAP) { atomicAdd(&bar[XB_TMO], 1u); break; } }
    }
    nloc = mine > 0u ? mine : 1u; nx = cnt > 0u ? cnt : 1u;
}
__device__ __forceinline__ void xcd_barrier(const XcdBarrier& b) {
    asm volatile("s_waitcnt vmcnt(0)" ::: "memory");
    __syncthreads();
    if (threadIdx.x == 0) {
        GAS unsigned* barg = (GAS unsigned*)b.bar; asm volatile("" : "+s"(barg)); unsigned* bar = (unsigned*)barg;
        unsigned bx = b.x; asm volatile("" : "+s"(bx));
        __builtin_amdgcn_s_waitcnt(0);
        unsigned nloc = b.st[0], nx = b.st[1];
        if (nloc == 0u) { xcd_barrier_complete(bar, bx, nloc, nx); b.st[0] = nloc; b.st[1] = nx; }
        const unsigned old = xb_add(&bar[XB_XSUB(bx)], 1u);
        const unsigned gen = old / nloc;
        if (old + 1u == (gen + 1u) * nloc) {
            __builtin_amdgcn_fence(__ATOMIC_RELEASE, "agent");
            asm volatile("s_waitcnt vmcnt(0)" ::: "memory");
            const unsigned og = xb_add(&bar[XB_TOP], 1u);
            const unsigned tg = og / nx;
            if (og + 1u == (tg + 1u) * nx) xb_add(&bar[XB_TOPGEN], 1u);
            else XB_SPIN(xb_ld(&bar[XB_TOPGEN]) == tg, bar);
            __builtin_amdgcn_fence(__ATOMIC_ACQUIRE, "agent");
            xb_add(&bar[XB_XGEN(bx)], 1u);
            asm volatile("s_waitcnt vmcnt(0)" ::: "memory");
        } else {
            XB_SPIN(xb_ld(&bar[XB_XGEN(bx)]) == gen, bar);
            __builtin_amdgcn_fence(__ATOMIC_ACQUIRE, "agent");
            asm volatile("s_waitcnt vmcnt(0)" ::: "memory");
        }
    }
    __syncthreads();
}

constexpr int LDS_BYTES = 147456;
constexpr int LDS_MISC = 131072;
struct Args { const float* in[33]; float* out; unsigned char* ws; int ph_lo, ph_hi; };
struct Frame { const float* const* in; float* out; unsigned char* ws; LAS unsigned char* lds; int tid, lane, wave, G, bid, wave0; };
#define IN_XP 0
#define IN_XS 1
#define IN_CK 2
#define IN_CV 3
#define IN_SF 4
#define IN_SB 5
#define IN_C 6
#define IN_CCTX 7
#define IN_WMOD 8
#define IN_BMOD 9
#define IN_GPRE1 10
#define IN_GPOST1 11
#define IN_GPRE2 12
#define IN_GPOST2 13
#define IN_WIN 14
#define IN_WA2F 15
#define IN_BAF 16
#define IN_WA2B 17
#define IN_BAB 18
#define IN_GGLA 19
#define IN_LQ1 20
#define IN_LK1 21
#define IN_LQ2 22
#define IN_LK2 23
#define IN_GDIFF 24
#define IN_WBRG 25
#define IN_WBRF 26
#define IN_WBRD 27
#define IN_WOUT 28
#define IN_WUP 29
#define IN_CONVW 30
#define IN_CONVB 31
#define IN_WDOWN 32
#define WSB(off) ((bf16_t*)(F.ws + (off)))
#define WSF(off) ((float*)(F.ws + (off)))

__device__ __forceinline__ void ph_prologue(const Frame& F) {
    LAS float* red = (LAS float*)F.lds;
    const float* cctx = F.in[IN_CCTX]; const float* cc = F.in[IN_C];
    LAS float* sl = (LAS float*)(F.lds + 32768);
    for (int i = F.tid; i < 3 * 2048; i += 512) sl[i] = silu_f(i < 2048 ? cctx[i] : cc[i - 2048]);
    __syncthreads();
    for (int it = F.bid; it < 384; it += F.G) {
        const int l = it / 192, col0 = (it % 192) * 64, kg = F.tid >> 4, cq = F.tid & 15;
        const float* W = F.in[IN_WMOD] + (size_t)l * 2048 * NMOD + col0 + 4 * cq;
        f32x4 a0 = {0.f, 0.f, 0.f, 0.f}, a1 = a0, a2 = a0;
#pragma unroll 16
        for (int kk = 0; kk < 64; ++kk) { const int k = kg * 64 + kk;
            const float s0 = sl[k], s1 = sl[2048 + k], s2 = sl[4096 + k];
            const f32x4 w = *(const f32x4*)(W + (size_t)k * NMOD);
            a0 += s0 * w; a1 += s1 * w; a2 += s2 * w; }
        *(LAS f32x4*)(red + (kg * 3 + 0) * 64 + 4 * cq) = a0; *(LAS f32x4*)(red + (kg * 3 + 1) * 64 + 4 * cq) = a1; *(LAS f32x4*)(red + (kg * 3 + 2) * 64 + 4 * cq) = a2;
        __syncthreads();
        if (F.tid < 192) { const int r = F.tid >> 6, col = F.tid & 63; float s = 0.f;
            for (int k2 = 0; k2 < 32; ++k2) s += red[(k2 * 3 + r) * 64 + col];
            WSF(WS_MOD)[(size_t)(l * 3 + r) * NMOD + col0 + col] = s + F.in[IN_BMOD][(size_t)l * NMOD + col0 + col]; }
        __syncthreads();
    }
    const size_t n512 = (size_t)1024 * 512 / 8, n256 = (size_t)256 * 512 / 8, n2048 = (size_t)1024 * 4096 / 8;
    const int tb0 = F.G > 128 ? 128 : 0;
    if (F.bid >= tb0)
    for (size_t i = (size_t)(F.bid - tb0) * 512 + F.tid; i < n512 + n256 + n2048; i += (size_t)(F.G - tb0) * 512) {
        float v[8]; bf16_t* dst;
        if (i < n512) { const int m = (int)(i / 64), c0 = (int)(i % 64) * 8, ch = m & 511, cs = m >> 9;
#pragma unroll
            for (int j = 0; j < 8; ++j) { const float rev = (float)((ch * (c0 + j)) & 511) * (1.0f / 512.0f); v[j] = (cs ? __builtin_amdgcn_sinf(rev) : __builtin_amdgcn_cosf(rev)) * 0.04419417382415922f; }
            dst = WSB(WS_T512) + (size_t)m * 512 + c0;
        } else if (i < n512 + n256) { const size_t q = i - n512; const int pos = (int)(q / 64), k0 = (int)(q % 64) * 8;
#pragma unroll
            for (int j = 0; j < 8; ++j) { const int kk = k0 + j, cs = kk >> 8, l = kk & 255; const float rev = (float)((pos * l) & 255) * (1.0f / 256.0f); v[j] = (cs ? -__builtin_amdgcn_sinf(rev) : __builtin_amdgcn_cosf(rev)) * 0.0625f; }
            dst = WSB(WS_T256) + (size_t)pos * 512 + k0;
        } else { const size_t q = i - n512 - n256; const int pos = (int)(q / 512), k0 = (int)(q % 512) * 8;
#pragma unroll
            for (int j = 0; j < 8; ++j) { const int kk = k0 + j, cs = kk >> 11, l = kk & 2047; const float rev = (float)((pos * l) & 2047) * (1.0f / 2048.0f); v[j] = (cs ? -__builtin_amdgcn_sinf(rev) : __builtin_amdgcn_cosf(rev)) * 0.022097086912079608f; }
            dst = WSB(WS_T2048) + (size_t)pos * 4096 + k0;
        }
        *(u32x4*)dst = pack8(v);
    }
}

template <int RMAP = 0>
__device__ __forceinline__ void transpose_item(const float* W, int ldw, int K, int c0, int nblk, bf16_t* WT, int r0, LAS float* scr, int item, int lane) {
    const int kb = item / nblk, nb = item % nblk, k0 = 64 * kb, n0 = 32 * nb;
    const int rd0 = (RMAP == 0) ? r0 + n0 : ((n0 < DFF) ? n0 + 128 * (n0 >> 7) : (n0 - DFF) + 128 * ((n0 - DFF) >> 7) + 128);
    float tv[32]; const float* wp = W + (size_t)(k0 + (lane >> 5)) * ldw + c0 + n0 + (lane & 31);
#pragma unroll
    for (int i = 0; i < 32; ++i) tv[i] = wp[(size_t)(2 * i) * ldw];
#pragma unroll
    for (int i = 0; i < 32; ++i) scr[(2 * i + (lane >> 5)) * 33 + (lane & 31)] = tv[i];
    asm volatile("s_waitcnt lgkmcnt(0)" ::: "memory");
    const int c = lane & 7;
#pragma unroll
    for (int j = 0; j < 4; ++j) { const int n = (lane >> 3) + 8 * j; const LAS float* s = scr + (8 * c) * 33 + n;
        u32x4 o; o.x = pk2(s[0 * 33], s[1 * 33]); o.y = pk2(s[2 * 33], s[3 * 33]); o.z = pk2(s[4 * 33], s[5 * 33]); o.w = pk2(s[6 * 33], s[7 * 33]);
        *(u32x4*)(WT + (size_t)(rd0 + n) * K + k0 + 8 * c) = o; }
    asm volatile("s_waitcnt lgkmcnt(0)" ::: "memory");
}
__device__ __forceinline__ void ph_weights(const Frame& F, int l) {
    LAS float* scr = (LAS float*)(F.lds + F.wave * 8448);
    const int gw = F.bid * 8 + F.wave, NGW = F.G * 8;
    const float* win = F.in[IN_WIN] + (size_t)l * 2048 * NIN_SRC;
    bf16_t* wt = WSB(WS_WIN);
    constexpr int T_IN = 32 * 641, T_BR = 32 * 64, T_UP = 32 * 352, T_DN = 88 * 64;
    constexpr int NIT = T_IN + 3 * T_BR + T_BR + T_UP + T_DN;
    for (int it = gw; it < NIT; it += NGW) {
        int r = it;
#define SEC(Wp, ldw, Kk, c0, nc, dst, r0) { constexpr int n_ = ((Kk) / 64) * ((nc) / 32); if (r < n_) { transpose_item(Wp, ldw, Kk, c0, (nc) / 32, dst, r0, scr, r, F.lane); continue; } r -= n_; }
        SEC(win, NIN_SRC, 2048, 0, 1024, wt, 0)
        SEC(win, NIN_SRC, 2048, 1024, 1024, wt, 1024)
        SEC(win, NIN_SRC, 2048, 4128, 2048, wt, 2048)
        SEC(win, NIN_SRC, 2048, 6176, 2048, wt, 4096)
        SEC(win, NIN_SRC, 2048, 8224, 2048, wt, 6144)
        SEC(win, NIN_SRC, 2048, 10272, 2048, wt, 8192)
        SEC(win, NIN_SRC, 2048, 12320, 2048, wt, 10240)
        SEC(win, NIN_SRC, 2048, 14368, 6144, wt, 12288)
        SEC(win, NIN_SRC, 2048, 4096, 32, wt, 18432)
        SEC(win, NIN_SRC, 2048, 2048, 2048, wt, 18688)
        SEC(F.in[IN_WBRG] + (size_t)l * 2048 * 2048, 2048, 2048, 0, 2048, WSB(WS_WBR), 0)
        SEC(F.in[IN_WBRF] + (size_t)l * 2048 * 2048, 2048, 2048, 0, 2048, WSB(WS_WBR), 2048)
        SEC(F.in[IN_WBRD] + (size_t)l * 2048 * 2048, 2048, 2048, 0, 2048, WSB(WS_WBR), 4096)
        SEC(F.in[IN_WOUT] + (size_t)l * 2048 * 2048, 2048, 2048, 0, 2048, WSB(WS_WOUT), 0)
        { constexpr int n_ = 32 * 352; if (r < n_) { transpose_item<1>(F.in[IN_WUP] + (size_t)l * 2048 * NUP, NUP, 2048, 0, 352, WSB(WS_WUP), 0, scr, r, F.lane); continue; } r -= n_; }
        SEC(F.in[IN_WDOWN] + (size_t)l * DFF * 2048, 2048, DFF, 0, 2048, WSB(WS_WDOWN), 0)
#undef SEC
    }
    { u32x4* z = (u32x4*)(wt + (size_t)18464 * 2048); const size_t n = (size_t)224 * 2048 * 2 / 16;
        unsigned z0 = 0u; asm volatile("" : "+v"(z0));
        for (size_t i = (size_t)F.bid * 512 + F.tid; i < n; i += (size_t)F.G * 512) z[i] = (u32x4){z0, z0, z0, z0}; }
}

__device__ __forceinline__ const float* x_row(const Frame& F, int l, int m) {
    if (l == 0) return m < RC ? F.in[IN_XP] + (size_t)m * D : F.in[IN_XS] + (size_t)(m - RC) * D;
    return F.out + (size_t)m * D;
}
__device__ __forceinline__ const float* mod_row(const Frame& F, int l, int m) { const int cond = m < RC ? 0 : 1 + ((m - RC) >> 11); return WSF(WS_MOD) + (size_t)(l * 3 + cond) * NMOD; }
__device__ __forceinline__ void ph_norm1(const Frame& F, int l) {
    const int gw = F.bid * 8 + F.wave, NGW = F.G * 8;
    const float* g = F.in[IN_GPRE1] + (size_t)l * D;
    for (int m0 = gw; m0 < R; m0 += 2 * NGW) {
        const bool ok1 = m0 + NGW < R; const int mm[2] = {m0, ok1 ? m0 + NGW : m0};
        f32x4 v[2][8];
#pragma unroll
        for (int u = 0; u < 2; ++u) { const f32x4* xr = (const f32x4*)x_row(F, l, mm[u]) + F.lane;
#pragma unroll
            for (int j = 0; j < 8; ++j) v[u][j] = xr[64 * j]; }
#pragma unroll
        for (int u = 0; u < 2; ++u) { float ss = 0.f;
#pragma unroll
            for (int j = 0; j < 8; ++j) ss += (v[u][j].x * v[u][j].x + v[u][j].y * v[u][j].y) + (v[u][j].z * v[u][j].z + v[u][j].w * v[u][j].w);
            const float rinv = rsqrtf(wave_sum(ss, F.lane) * (1.0f / D) + EPS); const float* md = mod_row(F, l, mm[u]);
            u32x2* o = (u32x2*)(WSB(WS_H) + (size_t)mm[u] * D) + F.lane;
            if (u == 0 || ok1) {
#pragma unroll
                for (int j = 0; j < 8; ++j) { const int c = 256 * j + 4 * F.lane; const f32x4 gg = *(const f32x4*)(g + c), sh = *(const f32x4*)(md + c), sc = *(const f32x4*)(md + 2048 + c);
                    const f32x4 y = v[u][j] * rinv * gg * (1.0f + sc) + sh; u32x2 w; w.x = pk2(y.x, y.y); w.y = pk2(y.z, y.w); o[64 * j] = w; } } }
    }
}
__device__ __forceinline__ void ph_cache(const Frame& F, int l) {
    const int gw = F.bid * 8 + F.wave, NGW = F.G * 8;
    for (int i = gw; i < 1024; i += NGW) { const int t = i >> 9, b = (i >> 8) & 1, j = i & 255;
        const f32x4* src = (const f32x4*)((t ? F.in[IN_CV] : F.in[IN_CK]) + ((size_t)(b * 2 + l) * 256 + j) * D) + F.lane;
        u32x2* o = (u32x2*)(WSB(t ? WS_DV : WS_DK) + (size_t)(RC + b * 2304 + j) * D) + F.lane;
#pragma unroll
        for (int jj = 0; jj < 8; ++jj) { const f32x4 y = src[64 * jj]; u32x2 w; w.x = pk2(y.x, y.y); w.y = pk2(y.z, y.w); o[64 * jj] = w; }
    }
}
template <bool XBF>
__device__ __forceinline__ void ph_mid(const Frame& F, int l) {
    const int gw = F.bid * 8 + F.wave, NGW = F.G * 8;
    const float* gp1 = F.in[IN_GPOST1] + (size_t)l * D; const float* g2 = F.in[IN_GPRE2] + (size_t)l * D;
    for (int m0 = gw; m0 < R; m0 += 2 * NGW) {
        const bool ok1 = m0 + NGW < R; const int mm[2] = {m0, ok1 ? m0 + NGW : m0};
        u32x2 yw[2][8], yw2[2][8]; f32x4 xv[2][8]; u32x2 xw[2][8];
#pragma unroll
        for (int u = 0; u < 2; ++u) { const u32x2* yr = (const u32x2*)(WSB(WS_YOUT) + (size_t)mm[u] * D) + F.lane;
            if constexpr (XBF) { const u32x2* xr = (const u32x2*)(WSB(WS_XB2) + (size_t)mm[u] * D) + F.lane;
#pragma unroll
                for (int j = 0; j < 8; ++j) { yw[u][j] = yr[64 * j]; xw[u][j] = xr[64 * j]; }
            } else { const f32x4* xr = (const f32x4*)x_row(F, 0, mm[u]) + F.lane;
#pragma unroll
                for (int j = 0; j < 8; ++j) { yw[u][j] = yr[64 * j]; xv[u][j] = xr[64 * j]; } }
            const bool latr = mm[u] >= RC; const u32x2* yr2 = (const u32x2*)(WSB(WS_KENDT) + (size_t)(latr ? mm[u] - RC : 0) * D) + F.lane;
#pragma unroll
            for (int j = 0; j < 8; ++j) yw2[u][j] = latr ? yr2[64 * j] : (u32x2){0u, 0u}; }
#pragma unroll
        for (int u = 0; u < 2; ++u) { const float* md = mod_row(F, l, mm[u]); f32x4 y[8]; float ss = 0.f;
#pragma unroll
            for (int j = 0; j < 8; ++j) { y[j] = (f32x4){lo16(yw[u][j].x) + lo16(yw2[u][j].x), hi16(yw[u][j].x) + hi16(yw2[u][j].x), lo16(yw[u][j].y) + lo16(yw2[u][j].y), hi16(yw[u][j].y) + hi16(yw2[u][j].y)}; ss += (y[j].x * y[j].x + y[j].y * y[j].y) + (y[j].z * y[j].z + y[j].w * y[j].w); }
            const float rinv = rsqrtf(wave_sum(ss, F.lane) * (1.0f / D) + EPS);
            float s2 = 0.f; u32x2* xo = (u32x2*)(WSB(WS_X1B) + (size_t)mm[u] * D) + F.lane; const bool st = (u == 0 || ok1);
#pragma unroll
            for (int j = 0; j < 8; ++j) { const int c = 256 * j + 4 * F.lane; const f32x4 gg = *(const f32x4*)(gp1 + c), gt = *(const f32x4*)(md + 4096 + c);
                f32x4 xin; if constexpr (XBF) xin = (f32x4){lo16(xw[u][j].x), hi16(xw[u][j].x), lo16(xw[u][j].y), hi16(xw[u][j].y)}; else xin = xv[u][j];
                const f32x4 x1 = xin + gt * (y[j] * rinv * gg); y[j] = x1; if (st) { u32x2 w; w.x = pk2(x1.x, x1.y); w.y = pk2(x1.z, x1.w); xo[64 * j] = w; } s2 += (x1.x * x1.x + x1.y * x1.y) + (x1.z * x1.z + x1.w * x1.w); }
            const float rinv2 = rsqrtf(wave_sum(s2, F.lane) * (1.0f / D) + EPS);
            u32x2* o = (u32x2*)(WSB(WS_H) + (size_t)mm[u] * D) + F.lane;
            if (st) {
#pragma unroll
                for (int j = 0; j < 8; ++j) { const int c = 256 * j + 4 * F.lane; const f32x4 gg = *(const f32x4*)(g2 + c), sh = *(const f32x4*)(md + 6144 + c), sc = *(const f32x4*)(md + 8192 + c);
                    const f32x4 h = y[j] * rinv2 * gg * (1.0f + sc) + sh; u32x2 w; w.x = pk2(h.x, h.y); w.y = pk2(h.z, h.w); o[64 * j] = w; } } }
    }
}
template <bool NEXT>
__device__ __forceinline__ void ph_final(const Frame& F, int l) {
    const int gw = F.bid * 8 + F.wave, NGW = F.G * 8;
    const float* gp2 = F.in[IN_GPOST2] + (size_t)l * D; const float* g1n = F.in[IN_GPRE1] + (size_t)(l + 1) * D;
    for (int m0 = gw; m0 < R; m0 += 2 * NGW) {
        const bool ok1 = m0 + NGW < R; const int mm[2] = {m0, ok1 ? m0 + NGW : m0};
        u32x2 ya[2][8], yb[2][8], xw[2][8];
#pragma unroll
        for (int u = 0; u < 2; ++u) { const u32x2* yr = (const u32x2*)(WSB(WS_YOUT) + (size_t)mm[u] * D) + F.lane; const u32x2* yr1 = (const u32x2*)(WSB(WS_OINTRA) + (size_t)mm[u] * D) + F.lane; const u32x2* xr = (const u32x2*)(WSB(WS_X1B) + (size_t)mm[u] * D) + F.lane;
#pragma unroll
            for (int j = 0; j < 8; ++j) { ya[u][j] = yr[64 * j]; yb[u][j] = yr1[64 * j]; xw[u][j] = xr[64 * j]; } }
#pragma unroll
        for (int u = 0; u < 2; ++u) { const float* md = mod_row(F, l, mm[u]); f32x4 y[8]; float ss = 0.f;
#pragma unroll
            for (int j = 0; j < 8; ++j) { y[j] = (f32x4){lo16(ya[u][j].x) + lo16(yb[u][j].x), hi16(ya[u][j].x) + hi16(yb[u][j].x), lo16(ya[u][j].y) + lo16(yb[u][j].y), hi16(ya[u][j].y) + hi16(yb[u][j].y)}; ss += (y[j].x * y[j].x + y[j].y * y[j].y) + (y[j].z * y[j].z + y[j].w * y[j].w); }
            const float rinv = rsqrtf(wave_sum(ss, F.lane) * (1.0f / D) + EPS);
            f32x4* xo = (f32x4*)(F.out + (size_t)mm[u] * D) + F.lane; u32x2* xo2 = (u32x2*)(WSB(WS_XB2) + (size_t)mm[u] * D) + F.lane; float s2 = 0.f; const bool st = (u == 0 || ok1);
#pragma unroll
            for (int j = 0; j < 8; ++j) { const int c = 256 * j + 4 * F.lane; const f32x4 gg = *(const f32x4*)(gp2 + c), gt = *(const f32x4*)(md + 10240 + c);
                const f32x4 xin = (f32x4){lo16(xw[u][j].x), hi16(xw[u][j].x), lo16(xw[u][j].y), hi16(xw[u][j].y)};
                const f32x4 x2 = xin + gt * (y[j] * rinv * gg);
                if (st) { if constexpr (NEXT) { u32x2 w; w.x = pk2(x2.x, x2.y); w.y = pk2(x2.z, x2.w); xo2[64 * j] = w; } else xo[64 * j] = x2; }
                y[j] = x2; s2 += (x2.x * x2.x + x2.y * x2.y) + (x2.z * x2.z + x2.w * x2.w); }
            if constexpr (NEXT) {
                const float rinv2 = rsqrtf(wave_sum(s2, F.lane) * (1.0f / D) + EPS); const float* mdn = mod_row(F, l + 1, mm[u]);
                u32x2* o = (u32x2*)(WSB(WS_H) + (size_t)mm[u] * D) + F.lane;
                if (st) {
#pragma unroll
                    for (int j = 0; j < 8; ++j) { const int c = 256 * j + 4 * F.lane; const f32x4 gg = *(const f32x4*)(g1n + c), sh = *(const f32x4*)(mdn + c), sc = *(const f32x4*)(mdn + 2048 + c);
                        const f32x4 h = y[j] * rinv2 * gg * (1.0f + sc) + sh; u32x2 w; w.x = pk2(h.x, h.y); w.y = pk2(h.z, h.w); o[64 * j] = w; } }
            } }
    }
}
__device__ __forceinline__ float diff_lambda(const Frame& F, int l, float& lam_init) {
    const float* q1 = F.in[IN_LQ1] + l * 128; const float* k1 = F.in[IN_LK1] + l * 128; const float* q2 = F.in[IN_LQ2] + l * 128; const float* k2 = F.in[IN_LK2] + l * 128;
    const float s1 = wave_sum(q1[F.lane] * k1[F.lane] + q1[64 + F.lane] * k1[64 + F.lane], F.lane);
    const float s2 = wave_sum(q2[F.lane] * k2[F.lane] + q2[64 + F.lane] * k2[64 + F.lane], F.lane);
    lam_init = 0.8f - 0.6f * __expf(-0.3f * (float)l);
    return __expf(s1) - __expf(s2) + lam_init;
}
__device__ __forceinline__ void ph_postmix(const Frame& F, int l) {
    const int gw = F.bid * 8 + F.wave, NGW = F.G * 8;
    float lam_init; const float lam = diff_lambda(F, l, lam_init);
    const float* ggla = F.in[IN_GGLA] + (size_t)l * 512 + 8 * F.lane; const float* gdiff = F.in[IN_GDIFF] + (size_t)l * 256 + 8 * (F.lane & 31);
    float gg[8], gd[8];
#pragma unroll
    for (int j = 0; j < 8; ++j) { gg[j] = ggla[j]; gd[j] = gdiff[j]; }
    for (int i = gw; i < 4096; i += NGW) { const int b = i >> 11, r = i & 2047;
        const bf16_t* yc = WSB(WS_Y) + (size_t)r * 24576 + 16384 + (size_t)b * 4096; float a = 0.f;
#pragma unroll
        for (int q = 0; q < 4; ++q) { float f[8]; unpack8(*(const u32x4*)(yc + (q * 64 + F.lane) * 8), f); a += ((f[0] - f[1]) + (f[2] - f[3])) + ((f[4] - f[5]) + (f[6] - f[7])); }
        a = wave_sum(a, F.lane) * 0.022097086912079608f;
        if (F.lane == 0) WSB(WS_OFNET)[(size_t)(RC + b * 2048 + 1024) * D + r] = (bf16_t)f2bf(a); }
    for (int i = F.bid * 512 + F.tid; i < 2 * 1023 * 256; i += F.G * 512) { const int c8 = i & 255, rest = i >> 8, b = rest / 1023, pos = 1025 + (rest - b * 1023), g = c8 >> 6, c0 = (c8 & 63) * 8;
        const bf16_t* srow = WSB(WS_OFNET) + (size_t)(RC + b * 2048 + (2048 - pos)) * D + g * 512;
        unsigned e[8];
#pragma unroll
        for (int j = 0; j < 8; ++j) e[j] = srow[(512 - (c0 + j)) & 511];
        u32x4 w; w.x = e[0] | (e[1] << 16); w.y = e[2] | (e[3] << 16); w.z = e[4] | (e[5] << 16); w.w = e[6] | (e[7] << 16);
        *(u32x4*)(WSB(WS_OFNET) + (size_t)(RC + b * 2048 + pos) * D + g * 512 + c0) = w; }
    for (int m = gw; m < R; m += NGW) {
        const size_t ro = (size_t)m * D + 8 * F.lane; const size_t po = (size_t)m * 4096 + (F.lane >> 5) * 512 + (F.lane & 31) * 8;
        u32x4 wa[4], wb[4], wc[4], wz[4], p1[4], p2[4];
#pragma unroll
        for (int q = 0; q < 4; ++q) { wa[q] = *(const u32x4*)(WSB(WS_OINTRA) + ro + 512 * q); wb[q] = *(const u32x4*)(WSB(WS_OF) + ro + 512 * q); wc[q] = *(const u32x4*)(WSB(WS_OB) + ro + 512 * q);
            wz[q] = *(const u32x4*)(WSB(WS_ZG) + ro + 512 * q); p1[q] = *(const u32x4*)(WSB(WS_OPART) + po + 1024 * q); p2[q] = *(const u32x4*)(WSB(WS_OPART) + po + 1024 * q + 256); }
#pragma unroll
        for (int q = 0; q < 4; ++q) {
            float a[8], b[8], c[8], zg[8], r[8]; unpack8(wa[q], a); unpack8(wb[q], b); unpack8(wc[q], c); unpack8(wz[q], zg); float ss = 0.f;
#pragma unroll
            for (int j = 0; j < 8; ++j) { a[j] += b[j] + c[j]; ss += a[j] * a[j]; }
            const float rinv = rsqrtf(wave_sum(ss, F.lane) * (1.0f / 512.0f) + EPS);
#pragma unroll
            for (int j = 0; j < 8; ++j) r[j] = a[j] * rinv * gg[j] * silu_f(zg[j]);
            *(u32x4*)(WSB(WS_AGLA) + ro + 512 * q) = pack8(r); }
#pragma unroll
        for (int q = 0; q < 4; ++q) {
            float a[8], b[8], r[8]; unpack8(p1[q], a); unpack8(p2[q], b); float ss = 0.f;
#pragma unroll
            for (int j = 0; j < 8; ++j) { a[j] -= lam * b[j]; ss += a[j] * a[j]; }
            ss += shx(ss, 1, F.lane); ss += shx(ss, 2, F.lane); ss += shx(ss, 4, F.lane); ss += shx(ss, 8, F.lane); ss += shx(ss, 16, F.lane);
            const float rinv = rsqrtf(ss * (1.0f / 256.0f) + EPS) * (1.0f - lam_init);
#pragma unroll
            for (int j = 0; j < 8; ++j) r[j] = a[j] * rinv * gd[j];
            *(u32x4*)(WSB(WS_ADIFF) + ro + 512 * q) = pack8(r); }
    }
}
__device__ __forceinline__ void ph_merge(const Frame& F) {
    const size_t n = (size_t)R * D / 8, st = (size_t)F.G * 512;
    const u32x4* p0 = (const u32x4*)(F.ws + WS_DQ); const u32x4* p1 = (const u32x4*)(F.ws + WS_DK); const u32x4* p2 = (const u32x4*)(F.ws + WS_DV); const u32x4* p3 = (const u32x4*)(F.ws + WS_QIN); u32x4* o = (u32x4*)(F.ws + WS_MERGED);
    for (size_t i = (size_t)F.bid * 512 + F.tid; i < n; i += 2 * st) { const size_t i2 = i + st; const bool has2 = i2 < n; const size_t j2 = has2 ? i2 : i;
        constexpr size_t lat0 = (size_t)RC * D / 8; const u32x4 zz = {0u, 0u, 0u, 0u};
        const u32x4 a0 = p0[i], b0 = p1[i], c0 = p2[i], a1 = p0[j2], b1 = p1[j2], c1 = p2[j2];
        const u32x4 d0 = i >= lat0 ? p3[i - lat0] : zz, d1 = j2 >= lat0 ? p3[j2 - lat0] : zz;
        float a[8], b[8], c[8], d[8]; unpack8(a0, a); unpack8(b0, b); unpack8(c0, c); unpack8(d0, d);
#pragma unroll
        for (int j = 0; j < 8; ++j) a[j] += (b[j] + c[j]) + d[j];
        o[i] = pack8(a);
        unpack8(a1, a); unpack8(b1, b); unpack8(c1, c); unpack8(d1, d);
#pragma unroll
        for (int j = 0; j < 8; ++j) a[j] += (b[j] + c[j]) + d[j];
        if (has2) o[i2] = pack8(a); }
}
__device__ __forceinline__ void ph_conv(const Frame& F, int l) {
    constexpr int NS = DFF / 8; const size_t n = (size_t)NS * (R / 32);
    const float* cw = F.in[IN_CONVW] + (size_t)l * 3 * DFF; const float* cb = F.in[IN_CONVB] + (size_t)l * DFF;
    const bf16_t* sg = WSB(WS_SG); const bf16_t* sv = WSB(WS_SV); bf16_t* A = WSB(WS_ACT);
    for (size_t i = (size_t)F.bid * 512 + F.tid; i < n; i += (size_t)F.G * 512) {
        const int j0 = (int)(i % NS) * 8, br = (int)(i / NS), q = br >> 1, last = br & 1, r = q * 64 + (last ? 63 : 0);
        if (r < 256 || (r < 512 && j0 < 2560)) continue;
        const int s = r < RC ? (r & 255) : ((r - RC) & 2047), Ls = r < RC ? 256 : 2048;
        const u32x4 zz = {0u, 0u, 0u, 0u};
        u32x4 gp, gc, gn, vv;
        if (!last) { gc = *(const u32x4*)(sg + (size_t)(q * 4 + 0) * DFF + j0); gn = *(const u32x4*)(sg + (size_t)(q * 4 + 1) * DFF + j0); gp = (s > 0) ? *(const u32x4*)(sg + (size_t)(q * 4 - 1) * DFF + j0) : zz; vv = *(const u32x4*)(sv + (size_t)(q * 2) * DFF + j0); }
        else { gc = *(const u32x4*)(sg + (size_t)(q * 4 + 3) * DFF + j0); gp = *(const u32x4*)(sg + (size_t)(q * 4 + 2) * DFF + j0); gn = (s < Ls - 1) ? *(const u32x4*)(sg + (size_t)(q * 4 + 4) * DFF + j0) : zz; vv = *(const u32x4*)(sv + (size_t)(q * 2 + 1) * DFF + j0); }
        float g0[8], g1[8], g2[8], val[8], rr[8]; unpack8(gp, g0); unpack8(gc, g1); unpack8(gn, g2); unpack8(vv, val);
#pragma unroll
        for (int j = 0; j < 8; ++j) { const float gt = g0[j] * cw[j0 + j] + g1[j] * cw[DFF + j0 + j] + g2[j] * cw[2 * DFF + j0 + j] + cb[j0 + j]; rr[j] = gelu_tanh_f(gt) * val[j]; }
        *(u32x4*)(A + (size_t)r * DFF + j0) = pack8(rr);
    }
    const bf16_t* P = WSB(WS_UPQ);
    for (int i = F.bid * 512 + F.tid; i < 64 * 256 * 16; i += F.G * 512) {
        const int t = i >> 12, r = (i >> 4) & 255, c0 = (i & 15) * 8, pm = t < 44 ? 0 : 1, pn = t < 44 ? t : t - 44, ch = pn * 128 + c0;
        float val[8], g0[8], g1[8], g2[8], rr[8];
#pragma unroll
        for (int j = 0; j < 8; ++j) { val[j] = 0.f; g0[j] = 0.f; g1[j] = 0.f; g2[j] = 0.f; }
        const u32x4 zz = {0u, 0u, 0u, 0u};
        u32x4 lv[4], lp[4], lc[4], ln[4];
#pragma unroll
        for (int kq = 0; kq < 4; ++kq) { const bf16_t* pr = P + ((size_t)(kq * 64 + t) * 256 + r) * 256 + c0;
            lv[kq] = *(const u32x4*)pr; lc[kq] = *(const u32x4*)(pr + 128); lp[kq] = (r > 0) ? *(const u32x4*)(pr + 128 - 256) : zz; ln[kq] = (r < 255) ? *(const u32x4*)(pr + 128 + 256) : zz; }
#pragma unroll
        for (int kq = 0; kq < 4; ++kq) { float a[8]; unpack8(lv[kq], a);
#pragma unroll
            for (int j = 0; j < 8; ++j) val[j] += a[j];
            unpack8(lp[kq], a);
#pragma unroll
            for (int j = 0; j < 8; ++j) g0[j] += a[j];
            unpack8(lc[kq], a);
#pragma unroll
            for (int j = 0; j < 8; ++j) g1[j] += a[j];
            unpack8(ln[kq], a);
#pragma unroll
            for (int j = 0; j < 8; ++j) g2[j] += a[j]; }
#pragma unroll
        for (int j = 0; j < 8; ++j) { const float gt = g0[j] * cw[ch + j] + g1[j] * cw[DFF + ch + j] + g2[j] * cw[2 * DFF + ch + j] + cb[ch + j]; rr[j] = gelu_tanh_f(gt) * val[j]; }
        *(u32x4*)(A + (size_t)(pm * 256 + r) * DFF + ch) = pack8(rr);
    }
}
__device__ __forceinline__ void ph_rope(const Frame& F) {
    const size_t n = (size_t)RL * 256;
    for (size_t i = (size_t)F.bid * 512 + F.tid; i < n; i += (size_t)F.G * 512) {
        const int rl = (int)(i >> 8), w = (int)(i & 255), isk = w >> 7, blk = (w >> 3) & 15, ax = (w >> 2) & 1, f0 = (w & 3) * 8;
        const int b = rl >> 11, s = rl & 2047; const float pos = (float)(ax ? (s & 63) : (s >> 6));
        bf16_t* p = (isk ? WSB(WS_DK) + (size_t)(RC + b * 2304 + 256 + s) * D : WSB(WS_DQ) + (size_t)(RC + rl) * D) + blk * 128 + ax * 64 + f0;
        float x1[8], x2[8], o1[8], o2[8]; unpack8(*(const u32x4*)p, x1); unpack8(*(const u32x4*)(p + 32), x2);
#pragma unroll
        for (int j = 0; j < 8; ++j) { const float inv = exp2f(-(float)(f0 + j) * (13.287712379549449f / 32.0f)); const float rev = pos * inv * 0.15915494309189535f;
            const float cs = __builtin_amdgcn_cosf(rev), sn = __builtin_amdgcn_sinf(rev); o1[j] = x1[j] * cs - x2[j] * sn; o2[j] = x2[j] * cs + x1[j] * sn; }
        *(u32x4*)p = pack8(o1); *(u32x4*)(p + 32) = pack8(o2);
    }
}

constexpr int GP_QIN = 0, GP_KIN = 33792, GP_AL = 67584, GP_X = 33792, GP_ZA = 100352, GP_TOT = 108800;
constexpr int GP_XS = 260, GP_ZS = 33;
template <int DIR>
__device__ __forceinline__ void gla_pre_dir(const Frame& F, int l, int item, int tok0, int h, f32x4 (&Aacc)[2], const u32x4 (&tq)[4], const u32x4 (&tk)[4], const float (&aw)[2][4], const float bias) {
    LAS bf16_t* qin = (LAS bf16_t*)(F.lds + GP_QIN); LAS bf16_t* kin = (LAS bf16_t*)(F.lds + GP_KIN); LAS float* tot = (LAS float*)(F.lds + GP_TOT); const LAS float* zal = (const LAS float*)(F.lds + GP_ZA);
    const int d = F.tid & 255, half = F.tid >> 8;
#pragma unroll
    for (int i = 0; i < 4; ++i) { const int p = F.tid + 512 * i, row = p >> 5, c16 = p & 31; *(LAS u32x4*)(qin + row * 264 + c16 * 8) = tq[i]; }
    {   LAS float* X = (LAS float*)(F.lds + GP_X);
        const int fr = F.lane & 15, fq = F.lane >> 4;
#pragma unroll
        for (int tt = 0; tt < 4; ++tt) { float bz[4];
#pragma unroll
            for (int s4 = 0; s4 < 4; ++s4) bz[s4] = zal[(16 * tt + fr) * GP_ZS + DIR * 16 + 4 * s4 + fq];
#pragma unroll
            for (int ct = 0; ct < 2; ++ct) { f32x4 acc = {0.f, 0.f, 0.f, 0.f};
#pragma unroll
                for (int s4 = 0; s4 < 4; ++s4) acc = __builtin_amdgcn_mfma_f32_16x16x4f32(aw[ct][s4], bz[s4], acc, 0, 0, 0);
                *(LAS f32x4*)(X + (16 * tt + fr) * GP_XS + 32 * F.wave + 16 * ct + 4 * fq) = acc; } } }
    __syncthreads();
    float cum[32]; float run = 0.f;
    {   const LAS float* xb = (const LAS float*)(F.lds + GP_X) + (32 * half) * GP_XS + d;
#pragma unroll
        for (int jj = 0; jj < 32; ++jj) { const float x = xb[(DIR ? 31 - jj : jj) * GP_XS] + bias; run += logsig_f(x) * 0.0625f; cum[jj] = run; } }
    tot[half * 256 + d] = run;
    __syncthreads();
#pragma unroll
    for (int i = 0; i < 4; ++i) { const int p = F.tid + 512 * i, row = p >> 5, c16 = p & 31; *(LAS u32x4*)(kin + row * 264 + c16 * 8) = tk[i]; }
    const int first = DIR ? 1 : 0; const float off = (half == first) ? 0.f : tot[first * 256 + d]; const float blast = tot[d] + tot[256 + d];
    const float ebl = __expf(blast);
    if (half == 0) WSF(WS_DECAY)[(size_t)(item * 2 + DIR) * 256 + d] = ebl;
    __syncthreads();
    LAS bf16_t* qb = qin + (32 * half) * 264 + d; LAS bf16_t* kb = kin + (32 * half) * 264 + d;
    bf16_t* ke_g = WSB(WS_KENDT) + ((size_t)(item * 2 + DIR) * 256 + d) * 64 + 32 * half;
#pragma unroll
    for (int g8 = 0; g8 < 4; ++g8) { float ke[8];
#pragma unroll
        for (int j8 = 0; j8 < 8; ++j8) { const int jj = 8 * g8 + j8; const int tl = (DIR ? 31 - jj : jj); const float b = cum[jj] + off;
            const float q = bf2f(qb[tl * 264]) * 0.0625f, k = bf2f(kb[tl * 264]);
            const float eb = __expf(b), ieb = __builtin_amdgcn_rcpf(eb); const float qi = q * eb, ki = k * ieb; ke[j8] = ki * ebl;
            qb[tl * 264] = (bf16_t)f2bf(qi); kb[tl * 264] = (bf16_t)f2bf(ki); if ((j8 & 1) == 1) asm volatile("" ::: "memory"); }
        u32x4 pk; int t0;
        if (DIR == 0) { pk.x = pk2(ke[0], ke[1]); pk.y = pk2(ke[2], ke[3]); pk.z = pk2(ke[4], ke[5]); pk.w = pk2(ke[6], ke[7]); t0 = 8 * g8; }
        else { pk.x = pk2(ke[7], ke[6]); pk.y = pk2(ke[5], ke[4]); pk.z = pk2(ke[3], ke[2]); pk.w = pk2(ke[1], ke[0]); t0 = 24 - 8 * g8; }
        *(u32x4*)(ke_g + t0) = pk; asm volatile("" ::: "memory"); }
    __syncthreads();
    {   bf16_t* qg = WSB(WS_QIN) + (size_t)DIR * R * 1024 + (size_t)tok0 * 1024 + h * 256;
#pragma unroll
        for (int i = 0; i < 4; ++i) { const int p = F.tid + 512 * i, row = p >> 5, c16 = p & 31;
            *(u32x4*)(qg + (size_t)row * 1024 + c16 * 8) = *(const LAS u32x4*)(qin + row * 264 + c16 * 8); } }
    const int tm = F.wave >> 1, lr = F.lane & 15, lq = F.lane >> 4;
#pragma unroll
    for (int t2 = 0; t2 < 2; ++t2) { const int tn = 2 * (F.wave & 1) + t2; f32x4 acc = {0.f, 0.f, 0.f, 0.f};
#pragma unroll
        for (int ks = 0; ks < 8; ++ks) { const bf16x8 a = *(const LAS bf16x8*)(qin + (16 * tm + lr) * 264 + 32 * ks + 8 * lq); const bf16x8 b = *(const LAS bf16x8*)(kin + (16 * tn + lr) * 264 + 32 * ks + 8 * lq);
            acc = __builtin_amdgcn_mfma_f32_16x16x32_bf16(a, b, acc, 0, 0, 0); }
#pragma unroll
        for (int i = 0; i < 4; ++i) { const int t = 16 * tm + 4 * lq + i, s = 16 * tn + lr; const bool keep = DIR ? (s >= t) : (s <= t); Aacc[t2][i] += keep ? acc[i] : 0.f; } }
    __syncthreads();
}
__device__ __forceinline__ void gla_pre_item(const Frame& F0, int l, int item) {
    Frame F = F0; F.tid = ltid(F.wave0); F.lane = F.tid & 63; F.wave = F.wave0;
    const int ch = item >> 2, h = item & 3, tok0 = ch * 64;
    LAS float* zal = (LAS float*)(F.lds + GP_ZA); LAS bf16_t* Al = (LAS bf16_t*)(F.lds + GP_AL);
    const int tm = F.wave >> 1, lr = F.lane & 15, lq = F.lane >> 4;
    f32x4 z4;
    {   const f32x4* zp_ = (const f32x4*)(WSF(WS_ZAP) + (size_t)tok0 * 32) + F.tid; constexpr size_t qs = (size_t)R * 32 / 4;
        const f32x4 z0 = zp_[0], z1 = zp_[qs], z2 = zp_[2 * qs], z3 = zp_[3 * qs]; z4 = (z0 + z1) + (z2 + z3); }
    u32x4 tq[4], tk[4];
    {   const bf16_t* zq = WSB(WS_ZQ) + (size_t)tok0 * 1024 + h * 256; const bf16_t* zk = WSB(WS_ZK) + (size_t)tok0 * 1024 + h * 256;
#pragma unroll
        for (int i = 0; i < 4; ++i) { const int p = F.tid + 512 * i, row = p >> 5, c16 = p & 31; tq[i] = *(const u32x4*)(zq + (size_t)row * 1024 + c16 * 8); tk[i] = *(const u32x4*)(zk + (size_t)row * 1024 + c16 * 8); } }
    bf16x8 va0[4], va1[4];
    {   const bf16_t* vt = WSB(WS_ZVT);
#pragma unroll
        for (int v4 = 0; v4 < 4; ++v4) { const bf16_t* vp = vt + (size_t)(h * 512 + 16 * (4 * F.wave + v4) + lr) * R + tok0 + 8 * lq; va0[v4] = *(const bf16x8*)vp; va1[v4] = *(const bf16x8*)(vp + 32); } }
    float awf[2][4], awb[2][4];
    {   const float* wf = F.in[IN_WA2F] + (size_t)l * 16 * 1024 + h * 256 + 32 * F.wave + lr; const float* wb = F.in[IN_WA2B] + (size_t)l * 16 * 1024 + h * 256 + 32 * F.wave + lr;
#pragma unroll
        for (int ct = 0; ct < 2; ++ct)
#pragma unroll
            for (int s4 = 0; s4 < 4; ++s4) { awf[ct][s4] = wf[(size_t)(4 * s4 + lq) * 1024 + 16 * ct]; awb[ct][s4] = wb[(size_t)(4 * s4 + lq) * 1024 + 16 * ct]; } }
    const float biasf = F.in[IN_BAF][(size_t)l * 1024 + h * 256 + (F.tid & 255)], biasb = F.in[IN_BAB][(size_t)l * 1024 + h * 256 + (F.tid & 255)];
    { LAS float* zp = zal + (F.tid >> 3) * GP_ZS + (F.tid & 7) * 4; zp[0] = z4.x; zp[1] = z4.y; zp[2] = z4.z; zp[3] = z4.w; }
    __syncthreads();
    f32x4 Aacc[2] = {{0.f, 0.f, 0.f, 0.f}, {0.f, 0.f, 0.f, 0.f}};
    gla_pre_dir<0>(F, l, item, tok0, h, Aacc, tq, tk, awf, biasf);
    gla_pre_dir<1>(F, l, item, tok0, h, Aacc, tq, tk, awb, biasb);
#pragma unroll
    for (int t2 = 0; t2 < 2; ++t2) { const int tn = 2 * (F.wave & 1) + t2;
#pragma unroll
        for (int i = 0; i < 4; ++i) Al[(16 * tm + 4 * lq + i) * 72 + 16 * tn + lr] = (bf16_t)f2bf(Aacc[t2][i]); }
    __syncthreads();
    bf16_t* oi = WSB(WS_OINTRA);
#pragma unroll
    for (int v4 = 0; v4 < 4; ++v4) { const int vtile = 4 * F.wave + v4;
        const bf16x8 a0 = va0[v4], a1 = va1[v4];
#pragma unroll
        for (int tt = 0; tt < 4; ++tt) { const bf16x8 b0 = *(const LAS bf16x8*)(Al + (16 * tt + lr) * 72 + 8 * lq), b1 = *(const LAS bf16x8*)(Al + (16 * tt + lr) * 72 + 32 + 8 * lq);
            f32x4 acc = {0.f, 0.f, 0.f, 0.f}; acc = __builtin_amdgcn_mfma_f32_16x16x32_bf16(a0, b0, acc, 0, 0, 0); acc = __builtin_amdgcn_mfma_f32_16x16x32_bf16(a1, b1, acc, 0, 0, 0);
            u32x2 w; w.x = pk2(acc[0], acc[1]); w.y = pk2(acc[2], acc[3]);
            *(u32x2*)(oi + (size_t)(tok0 + 16 * tt + lr) * D + h * 512 + 16 * vtile + 4 * lq) = w; } }
    __syncthreads();
}
constexpr int GS_Q = 0, GS_K = 65536, GS_D = 102400;
__device__ __forceinline__ void gla_scan_item(const Frame& F0, int l, int id) {
    Frame F = F0; F.tid = ltid(F.wave0); F.lane = F.tid & 63; F.wave = F.wave0;
    const bool lat = id < 32; const int j = lat ? id : id - 32;
    const int vs = j & 1, dir = (j >> 1) & 1, h = (j >> 2) & 3, b = j >> 4;
    const int cbase = lat ? 128 + 32 * b : 4 * b, nch = lat ? 32 : 4;
    LAS unsigned char* qsb = F.lds + GS_Q; LAS bf16_t* ksm = (LAS bf16_t*)(F.lds + GS_K); LAS float* dl = (LAS float*)(F.lds + GS_D);
    const int lr0 = F.lane & 15, lq0 = F.lane >> 4; const int vcol0 = h * 512 + vs * 256 + 32 * F.wave;
    f32x4 S[16][2];
    const size_t soff = ((size_t)((b * 2 + l) * 4 + h) * 256) * 512 + vs * 256 + 32 * F.wave + lr0;
    if (lat) { const float* st = F.in[dir ? IN_SB : IN_SF] + soff;
#pragma unroll
        for (int mt = 0; mt < 16; ++mt)
#pragma unroll
            for (int i = 0; i < 4; ++i) { S[mt][0][i] = st[(size_t)(16 * mt + 4 * lq0 + i) * 512]; S[mt][1][i] = st[(size_t)(16 * mt + 4 * lq0 + i) * 512 + 16]; if (i == 3) asm volatile("" ::: "memory"); }
    } else {
#pragma unroll
        for (int mt = 0; mt < 16; ++mt) { S[mt][0] = (f32x4){0.f, 0.f, 0.f, 0.f}; S[mt][1] = (f32x4){0.f, 0.f, 0.f, 0.f}; } }
    const bf16_t* qing = WSB(WS_QIN) + (size_t)dir * R * 1024 + h * 256; bf16_t* og = dir ? WSB(WS_OB) : WSB(WS_OF);
    u32x4 pk[4]; f32x4 pd; bf16x8 pv00, pv01, pv10, pv11;
#define GS_DMA_Q(ci_, T_) do { const int qrow0 = 2 * F.wave + (((T_) & 63) >> 5), qcp = (T_) & 31; const int gch_ = cbase + (dir ? nch - 1 - (ci_) : (ci_)); const bf16_t* qb_ = qing + (size_t)gch_ * 64 * 1024; \
        _Pragma("unroll") for (int i = 0; i < 4; ++i) { const int row_ = qrow0 + 16 * i, c_ = (qcp & 16) | ((qcp ^ row_) & 15); \
            __builtin_amdgcn_global_load_lds((const unsigned*)(qb_ + (size_t)row_ * 1024 + c_ * 8), (LAS unsigned*)(qsb + ((ci_) & 1) * 32768 + (8 * i + F.wave) * 1024), 16, 0, 0); } } while (0)
#define GS_LOAD_K(ci_, T_) do { const int lr_ = (T_) & 15, lq_ = ((T_) >> 4) & 3; const int gch_ = cbase + (dir ? nch - 1 - (ci_) : (ci_)), tok0_ = gch_ * 64, item_ = gch_ * 4 + h; \
        const bf16_t* keg_ = WSB(WS_KENDT) + (size_t)(item_ * 2 + dir) * 256 * 64; \
        _Pragma("unroll") for (int i = 0; i < 4; ++i) { const int p = (T_) + 512 * i; pk[i] = *(const u32x4*)(keg_ + (size_t)(p >> 3) * 64 + (p & 7) * 8); } \
        pd = *(const f32x4*)(WSF(WS_DECAY) + (size_t)(item_ * 2 + dir) * 256 + 4 * ((T_) & 63)); \
        const bf16_t* vp_ = WSB(WS_ZVT) + (size_t)(vcol0 + lr_) * R + tok0_ + 8 * lq_; pv00 = *(const bf16x8*)vp_; pv01 = *(const bf16x8*)(vp_ + 32); \
        pv10 = *(const bf16x8*)(vp_ + (size_t)16 * R); pv11 = *(const bf16x8*)(vp_ + (size_t)16 * R + 32); } while (0)
    GS_DMA_Q(0, F.tid); GS_LOAD_K(0, F.tid);
    for (int ci = 0; ci < nch; ++ci) {
        const int gch = cbase + (dir ? nch - 1 - ci : ci), tok0 = gch * 64;
        int tidc = F.tid; asm volatile("" : "+v"(tidc));
        const int lr = tidc & 15, lq = (tidc >> 4) & 3;
        asm volatile("s_waitcnt vmcnt(0)" ::: "memory");
#pragma unroll
        for (int i = 0; i < 4; ++i) { const int p = tidc + 512 * i; *(LAS u32x4*)(ksm + (p >> 3) * 72 + (p & 7) * 8) = pk[i]; }
        if (tidc < 64) *(LAS f32x4*)(dl + 4 * tidc) = pd;
        const bf16x8 vt00 = pv00, vt01 = pv01, vt10 = pv10, vt11 = pv11;
        __syncthreads();
        if (ci + 1 < nch) { GS_DMA_Q(ci + 1, tidc); GS_LOAD_K(ci + 1, tidc); }
        const LAS unsigned char* qs = qsb + (ci & 1) * 32768;
        f32x4 O[4][2];
#pragma unroll
        for (int tt = 0; tt < 4; ++tt) { O[tt][0] = (f32x4){0.f, 0.f, 0.f, 0.f}; O[tt][1] = (f32x4){0.f, 0.f, 0.f, 0.f}; }
#pragma unroll
        for (int ks = 0; ks < 8; ++ks) {
            u32x4 aw0, aw1;
            aw0.x = pk2(S[2 * ks][0][0], S[2 * ks][0][1]); aw0.y = pk2(S[2 * ks][0][2], S[2 * ks][0][3]); aw0.z = pk2(S[2 * ks + 1][0][0], S[2 * ks + 1][0][1]); aw0.w = pk2(S[2 * ks + 1][0][2], S[2 * ks + 1][0][3]);
            aw1.x = pk2(S[2 * ks][1][0], S[2 * ks][1][1]); aw1.y = pk2(S[2 * ks][1][2], S[2 * ks][1][3]); aw1.z = pk2(S[2 * ks + 1][1][0], S[2 * ks + 1][1][1]); aw1.w = pk2(S[2 * ks + 1][1][2], S[2 * ks + 1][1][3]);
            const bf16x8 af0 = __builtin_bit_cast(bf16x8, aw0), af1 = __builtin_bit_cast(bf16x8, aw1);
            const int c0 = 4 * ks + (lq >> 1), c1 = c0 + 2;
            const int o0 = ((c0 & 16) | ((c0 ^ lr) & 15)) * 16 + (lq & 1) * 8, o1 = ((c1 & 16) | ((c1 ^ lr) & 15)) * 16 + (lq & 1) * 8;
#pragma unroll
            for (int tt = 0; tt < 4; ++tt) { const LAS unsigned char* qp = qs + (16 * tt + lr) * 512;
                const u32x2 lo = *(const LAS u32x2*)(qp + o0), hi = *(const LAS u32x2*)(qp + o1); u32x4 bw; bw.x = lo.x; bw.y = lo.y; bw.z = hi.x; bw.w = hi.y; const bf16x8 bf = __builtin_bit_cast(bf16x8, bw);
                O[tt][0] = __builtin_amdgcn_mfma_f32_16x16x32_bf16(af0, bf, O[tt][0], 0, 0, 0); O[tt][1] = __builtin_amdgcn_mfma_f32_16x16x32_bf16(af1, bf, O[tt][1], 0, 0, 0); }
            asm volatile("" ::: "memory"); }
#pragma unroll
        for (int tt = 0; tt < 4; ++tt)
#pragma unroll
            for (int nt2 = 0; nt2 < 2; ++nt2) { u32x2 w; w.x = pk2(O[tt][nt2][0], O[tt][nt2][1]); w.y = pk2(O[tt][nt2][2], O[tt][nt2][3]);
                *(u32x2*)(og + (size_t)(tok0 + 16 * tt + lr) * D + vcol0 + 16 * nt2 + 4 * lq) = w; }
#pragma unroll
        for (int mt = 0; mt < 16; ++mt) { const f32x4 dv = *(const LAS f32x4*)(dl + 16 * mt + 4 * lq); S[mt][0] = S[mt][0] * dv; S[mt][1] = S[mt][1] * dv;
            const bf16x8 a0 = *(const LAS bf16x8*)(ksm + (16 * mt + lr) * 72 + 8 * lq), a1 = *(const LAS bf16x8*)(ksm + (16 * mt + lr) * 72 + 32 + 8 * lq);
            S[mt][0] = __builtin_amdgcn_mfma_f32_16x16x32_bf16(a0, vt00, S[mt][0], 0, 0, 0); S[mt][0] = __builtin_amdgcn_mfma_f32_16x16x32_bf16(a1, vt01, S[mt][0], 0, 0, 0);
            S[mt][1] = __builtin_amdgcn_mfma_f32_16x16x32_bf16(a0, vt10, S[mt][1], 0, 0, 0); S[mt][1] = __builtin_amdgcn_mfma_f32_16x16x32_bf16(a1, vt11, S[mt][1], 0, 0, 0);
            if (mt & 1) asm volatile("" ::: "memory"); }
        __syncthreads();
    }
#undef GS_DMA_Q
#undef GS_LOAD_K
    if (!lat) { const int te = ltid(F.wave0), lre = te & 15, lqe = (te >> 4) & 3;
        float* so = F.out + (dir ? O_SB : O_SF) + ((size_t)((b * 2 + l) * 4 + h) * 256) * 512 + vs * 256 + 32 * F.wave + lre;
#pragma unroll
        for (int mt = 0; mt < 16; ++mt)
#pragma unroll
            for (int i = 0; i < 4; ++i) { __builtin_nontemporal_store(S[mt][0][i], so + (size_t)(16 * mt + 4 * lqe + i) * 512); __builtin_nontemporal_store(S[mt][1][i], so + (size_t)(16 * mt + 4 * lqe + i) * 512 + 16); if (i == 3) asm volatile("" ::: "memory"); } }
}

__device__ __forceinline__ void attn_item(const Frame& F, int u) {
    int rowq, rowk, seq, h, c, vh;
    if (u < 512) { vh = u & 1; c = (u >> 1) & 1; const int qb = (u >> 2) & 7; h = (u >> 5) & 7; const int b = u >> 8; rowq = RC + b * 2048 + qb * 256; rowk = RC + b * 2304; seq = 2304; }
    else { const int v = u - 512; vh = v & 1; c = (v >> 1) & 1; h = (v >> 2) & 7; const int b = v >> 5; rowq = b * 256; rowk = b * 256; seq = 256; }
    const int rowqk = (u < 512) ? rowq : rowq;
    const bf16_t* Q = WSB(WS_DQ) + (size_t)rowqk * D + h * 256 + c * 128; const bf16_t* Kp = WSB(WS_DK) + (size_t)rowk * D + h * 256 + c * 128; const bf16_t* Vp = WSB(WS_DV) + (size_t)rowk * D + h * 256 + vh * 128;
    bf16_t* O = WSB(WS_OPART) + (size_t)rowq * 4096 + h * 512 + c * 256 + vh * 128;
    attn::attn_dense_body<2048, 2048, 4096>(Q, Kp, Vp, O, seq, (char*)F.lds, F.wave0);
    __syncthreads();
}

struct SchedIn { int G, c; const char* H; const char* W;
    __device__ __forceinline__ bool next(int i, pg8::Unit& u) const { const long L = (long)i * G + c; if (L >= 4032) return false;
        if (L >= 3840) { const int q = (int)L - 3840, pm = q >> 2, kq = q & 3;
            u.a = H + (size_t)pm * 256 * 2048 * 2 + (size_t)kq * 1024; u.b = W + (size_t)72 * 256 * 2048 * 2 + (size_t)kq * 1024; u.pm = pm; u.pn = 72; u.z = 2 + kq; u.nt = 8; return true; }
        const int x = (int)(L & 7), j = (int)(L >> 3);
        if (j < 432) { const int br = j >> 5, s = j & 31; int b, pnh = 0;
            if (br < 13) b = br * 8 + x; else { b = 104 + (x >> 1); pnh = 4 * (x & 1); }
            const int pm = 4 * (b % 12) + (s & 3), pn = 8 * (b / 12) + pnh + (s >> 2);
            u.a = H + (size_t)pm * 256 * 2048 * 2; u.b = W + (size_t)pn * 256 * 2048 * 2; u.pm = pm; u.pn = pn; u.z = 0; }
        else { const int jz = j - 432; int zb, s, pnh = 0;
            if (jz < 16) { zb = 8 + (x >> 1); s = jz; pnh = 4 * (x & 1); } else { zb = x; s = jz - 16; }
            const int pm = 4 * (zb & 1) + (s & 3), pn = 8 * (zb >> 1) + pnh + (s >> 2);
            u.a = W + (size_t)(NIN_MAIN + pm * 256) * 2048 * 2; u.b = H + (size_t)pn * 256 * 2048 * 2; u.pm = pm; u.pn = pn; u.z = 1; }
        return true; } };
struct SchedZa { int c; const char* H; const char* W;
    __device__ __forceinline__ bool next(int i, pg8::Unit& u) const { if (i != 0 || c >= 192) return false; const int pm = c >> 2, kq = c & 3;
        u.a = H + (size_t)pm * 256 * 2048 * 2 + (size_t)kq * 1024; u.b = W + (size_t)72 * 256 * 2048 * 2 + (size_t)kq * 1024; u.pm = pm; u.pn = 72; u.z = kq; return true; } };
struct SchedOne { pg8::Unit u0;
    __device__ __forceinline__ bool next(int i, pg8::Unit& u) const { if (i != 0) return false; u = u0; return true; } };
struct SchedBr { int G, c; const char* ws; int mode;
    __device__ __forceinline__ bool next(int i, pg8::Unit& u) const {
        int z, pm, pn; size_t koff = 0;
        const long L = (long)i * G + c; if (L >= 1280) return false;
        if (L < 768) { z = (int)L / 384; pg8::tile_order((int)L % 384, 48, 8, pm, pn); } else if (L < 1024) { z = 2; pg8::tile_order((int)L - 768, 32, 8, pm, pn); }
        else { const int cc = (int)L - 1024, kh = cc & 1, t = cc >> 1; pm = 32 + (t >> 3); pn = t & 7; z = 2 | (kh << 2); koff = (size_t)kh * 1024 * 2; u.nt = 16; }
        const int zb = z & 3; const size_t aoff = (zb == 0) ? WS_AGLA : ((zb == 1) ? WS_OFNET : WS_ADIFF);
        u.a = ws + aoff + (size_t)pm * 256 * 2048 * 2 + koff; u.b = ws + WS_WBR + (size_t)(zb * 2048 + pn * 256) * 2048 * 2 + koff; u.pm = pm; u.pn = pn; u.z = z; return true; } };
struct SchedOut { int G, c; const char* A; const char* B;
    __device__ __forceinline__ bool next(int i, pg8::Unit& u) const { const long L = (long)i * G + c; if (L >= 512) return false;
        if (L < 256) { int pm, pn; pg8::tile_order((int)L, 32, 8, pm, pn); u.a = A + (size_t)pm * 256 * 2048 * 2; u.b = B + (size_t)pn * 256 * 2048 * 2; u.pm = pm; u.pn = pn; u.z = 0; return true; }
        const int cc = (int)L - 256, kh = cc & 1, t = cc >> 1, pm = 32 + (t >> 3), pn = t & 7;
        u.a = A + (size_t)pm * 256 * 2048 * 2 + (size_t)kh * 2048; u.b = B + (size_t)pn * 256 * 2048 * 2 + (size_t)kh * 2048; u.pm = pm; u.pn = pn; u.z = kh; u.nt = 16; return true; } };
struct SchedOutHalf { int c; const char* A; const char* B;
    __device__ __forceinline__ bool next(int i, pg8::Unit& u) const { if (i != 0 || c >= 256) return false; const int kh = c & 1, t = c >> 1, pm = 32 + (t >> 3), pn = t & 7;
        u.a = A + (size_t)pm * 256 * 2048 * 2 + (size_t)kh * 2048; u.b = B + (size_t)pn * 256 * 2048 * 2 + (size_t)kh * 2048; u.pm = pm; u.pn = pn; u.z = kh; return true; } };
struct SchedPlain { int G, c, nM, nN; const char* A; const char* B; size_t sa, sb;
    __device__ __forceinline__ bool next(int i, pg8::Unit& u) const { const long L = (long)i * G + c; if (L >= (long)nM * nN) return false;
        int pm, pn; pg8::tile_order((int)L, nM, nN, pm, pn); u.a = A + (size_t)pm * sa; u.b = B + (size_t)pn * sb; u.pm = pm; u.pn = pn; u.z = 0; return true; } };
struct SchedUp { int G, c; const char* A; const char* B;
    __device__ __forceinline__ bool next(int i, pg8::Unit& u) const { const long L = (long)i * G + c; if (L >= 2304) return false;
        if (L >= 2048) { const int q = (int)L - 2048, t = q >> 2, kq = q & 3, pm = t < 44 ? 0 : 1, pn = t < 44 ? t : t - 44;
            u.a = A + (size_t)pm * 256 * 2048 * 2 + (size_t)kq * 1024; u.b = B + (size_t)pn * 256 * 2048 * 2 + (size_t)kq * 1024; u.pm = kq * 64 + t; u.pn = 0; u.z = 1; u.nt = 8; return true; }
        int pm, pn; if (L < 2024) { pg8::tile_order((int)L, 46, 44, pm, pn); pm += 2; } else { pm = 1; pn = 20 + ((int)L - 2024); }
        u.a = A + (size_t)pm * 256 * 2048 * 2; u.b = B + (size_t)pn * 256 * 2048 * 2; u.pm = pm; u.pn = pn; u.z = 0; return true; } };
struct SchedUpQ { int c; const char* A; const char* B;
    __device__ __forceinline__ bool next(int i, pg8::Unit& u) const { if (i != 0 || c >= 256) return false; const int t = c >> 2, kq = c & 3, pm = t < 44 ? 0 : 1, pn = t < 44 ? t : t - 44;
        u.a = A + (size_t)pm * 256 * 2048 * 2 + (size_t)kq * 1024; u.b = B + (size_t)pn * 256 * 2048 * 2 + (size_t)kq * 1024; u.pm = kq * 64 + t; u.pn = 0; u.z = 0; return true; } };
struct SchedDown { int G, c; const char* A; const char* B;
    __device__ __forceinline__ bool next(int i, pg8::Unit& u) const { const long L = (long)i * G + c; if (L >= 768) return false;
        const int z = (int)L / 384; int pm, pn; pg8::tile_order((int)L % 384, 48, 8, pm, pn);
        u.a = A + ((size_t)pm * 256 * DFF + (size_t)z * (DFF / 2)) * 2; u.b = B + ((size_t)pn * 256 * DFF + (size_t)z * (DFF / 2)) * 2; u.pm = pm; u.pn = pn; u.z = z; return true; } };
struct SchedF1 { int G, c; const char* T; const char* ZF;
    __device__ __forceinline__ bool next(int i, pg8::Unit& u) const { const long L = (long)i * G + c; if (L >= 768) return false;
        const int z = (int)L / 192, r = (int)L % 192, pm = r & 3, pn = r >> 2;
        u.a = T + (size_t)pm * 256 * 512 * 2; u.b = ZF + ((size_t)z * R + (size_t)pn * 256) * 512 * 2; u.pm = pm; u.pn = pn; u.z = z; return true; } };
struct SchedF2c { int G, c; const char* T; const char* Y;
    __device__ __forceinline__ bool next(int i, pg8::Unit& u) const { const long L = (long)i * G + c; if (L >= 256) return false;
        const int b = (int)L >> 3, pn = (int)L & 7; u.a = T; u.b = Y + ((size_t)pn * 256 * 24576 + (size_t)b * 512) * 2; u.pm = b; u.pn = pn; u.z = 0; return true; } };
struct SchedF2l { int G, c; const char* T; const char* Y;
    __device__ __forceinline__ bool next(int i, pg8::Unit& u) const { const long L = (long)i * G + c; if (L >= 64) return false;
        const int b = (int)L >> 5, p8 = ((int)L >> 3) & 3, pn = (int)L & 7;
        u.a = T + (size_t)p8 * 256 * 4096 * 2; u.b = Y + ((size_t)pn * 256 * 24576 + 16384 + (size_t)b * 4096) * 2; u.pm = 32 + b * 8 + p8; u.pn = pn; u.z = 0; return true; } };

__global__ void __launch_bounds__(512, 2) mega(Args args) {
    extern __shared__ __attribute__((aligned(16))) unsigned char lds_raw[];
    Frame F; F.in = args.in; F.out = args.out; F.ws = args.ws; F.lds = (LAS unsigned char*)lds_raw;
    F.wave0 = __builtin_amdgcn_readfirstlane((int)threadIdx.x >> 6); F.tid = ltid(F.wave0); F.lane = F.tid & 63; F.wave = F.wave0; F.G = gridDim.x; F.bid = blockIdx.x;
    unsigned* ctl = (unsigned*)(F.ws + WS_CTL);
    for (int u = F.tid; u < (LDS_BYTES - LDS_MISC) / 4; u += 512) ((LAS unsigned*)(F.lds + LDS_MISC))[u] = 0u;
    __syncthreads();
    const int lo = args.ph_lo, hi = args.ph_hi;
    XcdBarrier bar; bar.bar = ctl + CW_BAR; bar.x = 0; bar.st = nullptr;
    if (hi - lo > 1) bar = xcd_barrier_post(ctl + CW_BAR, (volatile LAS unsigned*)(F.lds + LDS_MISC + 32));
#ifndef PH_MASK
#define PH_MASK 0x3fff
#endif
#define RELAUNDER() do { F.tid = ltid(F.wave0); F.lane = F.tid & 63; F.wave = F.wave0; { int b_ = (int)blockIdx.x; asm volatile("" : "+s"(b_)); F.bid = b_; } { GAS unsigned char* w_ = (GAS unsigned char*)args.ws; asm volatile("" : "+s"(w_)); F.ws = (unsigned char*)w_; } { GAS float* o_ = (GAS float*)args.out; asm volatile("" : "+s"(o_)); F.out = (float*)o_; } } while (0)
#ifndef PROBE_REP
#define PROBE_REP 0
#endif
#define REPS(j) ((((PROBE_REP) >> (j)) & 1) ? 2 : 1)
#define IN(k) (lo <= (k) && (k) < hi)
#define INJ(j) ((((PH_MASK) >> ((j) + 1)) & 1) && IN(pb + (j)))
#define SEAM(k) do { if (IN(k) && IN((k) + 1)) xcd_barrier(bar); } while (0)
    if ((PH_MASK & 1) && IN(0)) { RELAUNDER(); ph_prologue(F); } SEAM(0);
    for (int l = 0; l < 2; ++l) {
        const int pb = 1 + 13 * l;
        if (l == 0) { if (INJ(0)) { RELAUNDER(); ph_weights(F, 0); RELAUNDER(); ph_norm1(F, 0); ph_cache(F, 0); } SEAM(pb + 0); }
        if (INJ(1)) { for (int rep_ = 0; rep_ < REPS(1); ++rep_) { RELAUNDER();
            pg8::Gemm g{2048, 2048, 2048}; SchedIn S{F.G, F.bid, (const char*)F.ws + WS_H, (const char*)F.ws + WS_WIN};
            pg8::EpiIn E{F.ws, F.out, l};
            pg8::gemm_phase<pg8::EpiIn, SchedIn, true, true>(F.lds, g, S, E, F.wave0);
            }
        } SEAM(pb + 1);
        if (INJ(2)) { RELAUNDER();
#ifndef SUB
#define SUB 0xff
#endif
            if (SUB & 1) for (int rep_ = 0; rep_ < REPS(2); ++rep_) for (int it = F.bid; it < 768; it += F.G) gla_pre_item(F, l, it);
            RELAUNDER();
            if (SUB & 2) ph_rope(F);
            RELAUNDER();
            if (SUB & 4) for (int rep_ = 0; rep_ < REPS(2); ++rep_) { RELAUNDER();
            pg8::Gemm g{512, 512, 512}; SchedF1 S{F.G, F.bid, (const char*)F.ws + WS_T512, (const char*)F.ws + WS_ZF}; pg8::EpiY E{WSB(WS_Y)};
            pg8::gemm_phase<pg8::EpiY, SchedF1, true, true>(F.lds, g, S, E, F.wave0); }
        } SEAM(pb + 2);
        if (INJ(3)) { RELAUNDER();
            { pg8::Gemm g{4096, 24576, 4096}; SchedF2l S{F.G, F.bid, (const char*)F.ws + WS_T2048, (const char*)F.ws + WS_Y}; pg8::EpiBf16 E{WSB(WS_OFNET), 2048};
              pg8::gemm_phase<pg8::EpiBf16, SchedF2l, true, true>(F.lds, g, S, E, F.wave0); }
            RELAUNDER();
            {   LAS int* qslot = (LAS int*)(F.lds + LDS_MISC + 64);
                for (;;) {
                    if (F.tid == 0) *qslot = (int)__hip_atomic_fetch_add(ctl + CW_Q + 64 * l, 1u, __ATOMIC_RELAXED, __HIP_MEMORY_SCOPE_AGENT);
                    __syncthreads(); const int id = *qslot; __syncthreads();
                    if (id >= 2080) break;
                    if (id < 32 || (id >= 544 && id < 1056)) gla_scan_item(F, l, id < 32 ? id : id - 544 + 32);
                    else attn_item(F, id < 544 ? id - 32 : id - 1056 + 512);
                }
            }
            RELAUNDER();
            { pg8::Gemm g{512, 24576, 512}; SchedF2c S{F.G, F.bid, (const char*)F.ws + WS_T256, (const char*)F.ws + WS_Y}; pg8::EpiBf16 E{WSB(WS_OFNET), 2048};
              pg8::gemm_phase<pg8::EpiBf16, SchedF2c, true, true>(F.lds, g, S, E, F.wave0); }
        } SEAM(pb + 3);
        if (INJ(4)) { for (int rep_ = 0; rep_ < REPS(4); ++rep_) { RELAUNDER(); ph_postmix(F, l); } } SEAM(pb + 4);
        if (INJ(5)) { for (int rep_ = 0; rep_ < REPS(5); ++rep_) { RELAUNDER();
            { pg8::Gemm g{2048, 2048, 2048}; SchedBr S{F.G, F.bid, (const char*)F.ws, 0}; pg8::EpiBr E{F.ws + WS_P, WSB(WS_GATE)};
              pg8::gemm_phase<pg8::EpiBr, SchedBr, true, true>(F.lds, g, S, E, F.wave0); } }
        } SEAM(pb + 5);
        if (INJ(6)) { for (int rep_ = 0; rep_ < REPS(6); ++rep_) { RELAUNDER(); ph_merge(F); } } SEAM(pb + 6);
        if (INJ(7)) { for (int rep_ = 0; rep_ < REPS(7); ++rep_) { RELAUNDER();
            { pg8::Gemm g{2048, 2048, 2048}; SchedOut S{F.G, F.bid, (const char*)F.ws + WS_MERGED, (const char*)F.ws + WS_WOUT}; pg8::EpiBf16 E{WSB(WS_YOUT), 2048, WSB(WS_KENDT), RC};
              pg8::gemm_phase<pg8::EpiBf16, SchedOut, true, true>(F.lds, g, S, E, F.wave0); } }
        } SEAM(pb + 7);
        if (INJ(8)) { RELAUNDER(); if (l == 0) ph_mid<false>(F, 0); else ph_mid<true>(F, 1); } SEAM(pb + 8);
        if (INJ(9)) { for (int rep_ = 0; rep_ < REPS(9); ++rep_) { RELAUNDER();
            pg8::Gemm g{2048, 2048, 2048}; SchedUp S{F.G, F.bid, (const char*)F.ws + WS_H, (const char*)F.ws + WS_WUP}; pg8::EpiFfn E{WSB(WS_ACT), WSB(WS_SG), WSB(WS_SV), F.in[IN_CONVW] + (size_t)l * 3 * DFF, F.in[IN_CONVB] + (size_t)l * DFF, WSB(WS_UPQ)};
            pg8::gemm_phase<pg8::EpiFfn, SchedUp, true, true>(F.lds, g, S, E, F.wave0);
            }
        } SEAM(pb + 9);
        if (INJ(10)) { for (int rep_ = 0; rep_ < REPS(10); ++rep_) { RELAUNDER(); ph_conv(F, l); } } SEAM(pb + 10);
        if (INJ(11)) { for (int rep_ = 0; rep_ < REPS(11); ++rep_) { RELAUNDER();
            pg8::Gemm g{DFF, DFF, DFF / 2}; SchedDown S{F.G, F.bid, (const char*)F.ws + WS_ACT, (const char*)F.ws + WS_WDOWN}; pg8::EpiBf16z E{F.ws};
            pg8::gemm_phase<pg8::EpiBf16z, SchedDown, true, true>(F.lds, g, S, E, F.wave0); }
        } SEAM(pb + 11);
        if (INJ(12)) { RELAUNDER();
            if (l == 0) { ph_weights(F, 1); RELAUNDER(); ph_final<true>(F, 0); ph_cache(F, 1); } else ph_final<false>(F, 1); }
        if (l == 0) { if (IN(pb + 12) && IN(pb + 14)) xcd_barrier(bar); }
    }
#undef IN
#undef SEAM
}

extern "C" void kernel_launch(void* const* d_in, const int* in_sizes, int n_in, void* d_out, int out_size, void* d_ws, size_t ws_size, hipStream_t stream) {
    static int grid = 0;
    if (grid == 0) {
        if (n_in != 33 || (size_t)out_size != O_END || ws_size < WS_END) { fprintf(stderr, "kernel_launch: unexpected shapes (n_in %d out %d ws %zu)\n", n_in, out_size, ws_size); grid = -1; return; }
        int dev = 0, cus = 0, per_cu = 0;
        if (hipGetDevice(&dev) != hipSuccess || hipDeviceGetAttribute(&cus, hipDeviceAttributeMultiprocessorCount, dev) != hipSuccess) { grid = -1; return; }
        if (hipFuncSetAttribute((const void*)mega, hipFuncAttributeMaxDynamicSharedMemorySize, LDS_BYTES) != hipSuccess) { fprintf(stderr, "kernel_launch: hipFuncSetAttribute failed\n"); grid = -1; return; }
        if (hipOccupancyMaxActiveBlocksPerMultiprocessor(&per_cu, (const void*)mega, 512, LDS_BYTES) != hipSuccess || per_cu < 1) { fprintf(stderr, "kernel_launch: occupancy query says %d\n", per_cu); }
        (void)hipGetLastError();
        grid = cus;
    }
    if (grid < 0) return;
    (void)hipMemsetAsync((char*)d_ws + WS_CTL, 0, CTL_BYTES, stream);
    Args a{};
    for (int i = 0; i < 33; ++i) a.in[i] = (const float*)d_in[i];
    a.out = (float*)d_out; a.ws = (unsigned char*)d_ws;
#if MK_MODE == 0
    a.ph_lo = 0; a.ph_hi = NPH;
    hipLaunchKernelGGL(mega, dim3(grid), dim3(512), LDS_BYTES, stream, a);
#else
    for (int p = 0; p < NPH; ++p) { a.ph_lo = p; a.ph_hi = p + 1; hipLaunchKernelGGL(mega, dim3(grid), dim3(512), LDS_BYTES, stream, a); }
#endif
}
```

```cpp
#include <hip/hip_runtime.h>
#include <cstdio>
#include <cstdint>

#ifndef MK_MODE
#define MK_MODE 0
#endif
#ifndef MK_DBG
#define MK_DBG 0
#endif

#define LAS __attribute__((address_space(3)))
#define GAS __attribute__((address_space(1)))
typedef unsigned short bf16_t;
typedef short bf16x8 __attribute__((ext_vector_type(8)));
typedef short s16x4 __attribute__((ext_vector_type(4)));
typedef float f32x4 __attribute__((ext_vector_type(4)));
typedef float f32x2 __attribute__((ext_vector_type(2)));
typedef float f32x8 __attribute__((ext_vector_type(8)));
typedef float f32x16 __attribute__((ext_vector_type(16)));
typedef unsigned u32x4 __attribute__((ext_vector_type(4)));
typedef unsigned u32x2 __attribute__((ext_vector_type(2)));

constexpr int D = 2048, RC = 8192, RL = 4096, R = 12288, NBC = 32, LC = 256, NBL = 2, LL = 2048, PAST = 256;
constexpr int DFF = 5632, NUP = 11264, NMOD = 12288, NIN_SRC = 20512, NIN_MAIN = 18688, NIN_PAD = 20736;
constexpr int KROWS = RC + NBL * (PAST + LL);
constexpr float EPS = 1e-6f;
constexpr int NPH = 27;
constexpr size_t O_Y = 0, O_NK = 25165824, O_NV = 58720256, O_SF = 92274688, O_SB = 125829120, O_END = 159383552;
constexpr size_t MiB = 1u << 20;
constexpr size_t WS_CTL = 0, CTL_BYTES = 1 * MiB;
constexpr size_t WS_MOD = 1 * MiB, WS_DECAY = 2 * MiB, WS_ZA = 4 * MiB, WS_T512 = 6 * MiB, WS_T256 = 7 * MiB, WS_T2048 = 8 * MiB;
constexpr size_t WS_WIN = 24 * MiB, WS_WBR = 105 * MiB, WS_WOUT = 129 * MiB, WS_WUP = 137 * MiB, WS_WDOWN = 181 * MiB;
constexpr size_t WS_H = 203 * MiB, WS_ZQ = 251 * MiB, WS_ZK = 275 * MiB, WS_ZVT = 299 * MiB, WS_ZG = 347 * MiB, WS_DQ = 395 * MiB, WS_DK = 443 * MiB, WS_DV = 493 * MiB;
constexpr size_t WS_ZF = 543 * MiB, WS_GATE = 591 * MiB, WS_QIN = 735 * MiB, WS_KENDT = 783 * MiB, WS_Y = 831 * MiB, WS_OINTRA = 927 * MiB, WS_OPART = 975 * MiB;
constexpr size_t WS_OF = 1071 * MiB, WS_OB = 1119 * MiB, WS_OFNET = 1167 * MiB, WS_SG = 1215 * MiB, WS_SV = 1224 * MiB, WS_XB2 = 1230 * MiB  , WS_END = 1278 * MiB;
constexpr size_t WS_MERGED = WS_H, WS_AGLA = WS_ZQ, WS_ADIFF = WS_ZF, WS_P = WS_DQ  , WS_YOUT = WS_Y, WS_U = WS_OINTRA, WS_ACT = WS_GATE, WS_X1B = WS_OF  , WS_UPQ = WS_OPART  , WS_ZAP = WS_OPART  ;
constexpr int CW_BAR = 4096;
constexpr int CW_Q = 1024;
constexpr int CW_ERR = 2048;

__device__ __forceinline__ float bf2f(bf16_t b) { return __uint_as_float(((unsigned)b) << 16); }
typedef __bf16 bf16x2_t __attribute__((ext_vector_type(2)));
__device__ __forceinline__ unsigned pk2(float lo, float hi) { const f32x2 v = {lo, hi}; const bf16x2_t b = __builtin_convertvector(v, bf16x2_t); return __builtin_bit_cast(unsigned, b); }
__device__ __forceinline__ unsigned f2bf(float f) { return pk2(f, 0.f) & 0xffffu; }
__device__ __forceinline__ float lo16(unsigned w) { return __uint_as_float(w << 16); }
__device__ __forceinline__ float hi16(unsigned w) { return __uint_as_float(w & 0xffff0000u); }
__device__ __forceinline__ unsigned cvt_pk_bf16(float lo, float hi) { unsigned r; asm volatile("v_cvt_pk_bf16_f32 %0, %1, %2" : "=v"(r) : "v"(lo), "v"(hi)); return r; }
__device__ __forceinline__ float shx(float v, int mask, int lane) { return __int_as_float(__builtin_amdgcn_ds_bpermute((lane ^ mask) << 2, __float_as_int(v))); }
__device__ __forceinline__ float wave_sum(float v, int lane) {
#pragma unroll
    for (int o = 1; o < 64; o <<= 1) v += shx(v, o, lane);
    return v;
}
__device__ __forceinline__ int ltid(int wave) { unsigned z = 0u; asm volatile("" : "+s"(z));
    int t = (wave << 6) | (int)__builtin_amdgcn_mbcnt_hi(~0u, __builtin_amdgcn_mbcnt_lo(~0u, z)); asm volatile("" : "+v"(t)); return t; }
__device__ __forceinline__ float sigmoid_f(float x) { return __builtin_amdgcn_rcpf(1.0f + __builtin_amdgcn_exp2f(-1.4426950408889634f * x)); }
__device__ __forceinline__ float silu_f(float x) { return x * sigmoid_f(x); }
__device__ __forceinline__ float logsig_f(float x) { return fminf(x, 0.0f) - 0.6931471805599453f * __builtin_amdgcn_logf(1.0f + __builtin_amdgcn_exp2f(-1.4426950408889634f * fabsf(x))); }
__device__ __forceinline__ float gelu_tanh_f(float x) { const float u2 = 1.5957691216057308f * (x + 0.044715f * x * x * x); return x * sigmoid_f(u2); }
__device__ __forceinline__ void unpack8(const u32x4 w, float (&f)[8]) { f[0] = lo16(w.x); f[1] = hi16(w.x); f[2] = lo16(w.y); f[3] = hi16(w.y); f[4] = lo16(w.z); f[5] = hi16(w.z); f[6] = lo16(w.w); f[7] = hi16(w.w); }
__device__ __forceinline__ u32x4 pack8(const float (&f)[8]) { u32x4 w; w.x = pk2(f[0], f[1]); w.y = pk2(f[2], f[3]); w.z = pk2(f[4], f[5]); w.w = pk2(f[6], f[7]); return w; }

namespace pg8 {
#define PG8_LAS __attribute__((address_space(3)))
constexpr int BM = 256, BK = 64, HALF = 128, HTB = HALF * BK * 2, STAGE_BYTES = 8 * HTB, NXCD = 8, WGM = 4;
__device__ __forceinline__ int lds_byte(int r, int c) { const int st = (r >> 4) * 2 + (c >> 5), rr = r & 15, cc = c & 31, ob = rr * 64 + cc * 2; return st * 1024 + (ob ^ (((ob >> 9) & 1) << 5)); }
__device__ __forceinline__ void stage_rc(int b, int& Rr, int& C) { const int st = b / 1024, sb = b % 1024, swz = sb ^ (((sb >> 9) & 1) << 5); Rr = (st >> 1) * 16 + swz / 64; C = (st & 1) * 32 + (swz % 64) / 2; }
__device__ __forceinline__ int perm32(int rho) { const int n = rho >> 4, i = rho & 15; return 8 * (i >> 2) + 4 * n + (i & 3); }
struct Unit { const char* a; const char* b; int pm, pn, z, nt; };
struct Gemm { int lda, ldb, K; };
__device__ __forceinline__ void tile_order(int L, int nM, int nN, int& pm, int& pn) {
    const int nwg = nM * nN; int wgid = L;
    { const int q = nwg / NXCD, r = nwg % NXCD, xcd = wgid % NXCD, off = wgid / NXCD; wgid = (xcd < r ? xcd * (q + 1) : r * (q + 1) + (xcd - r) * q) + off; }
    const int nig = WGM * nN, gid = wgid / nig, fm = gid * WGM, gsz = (nM - fm) < WGM ? (nM - fm) : WGM;
    pm = fm + ((wgid % nig) % gsz); pn = (wgid % nig) / gsz;
}
typedef f32x4 Acc[2][2][4][2];

template <class Epi, class Sched, bool ALIGN_EPI = false, bool SP2 = false>
__device__ __forceinline__ void gemm_phase(PG8_LAS unsigned char* lds, const Gemm g, const Sched& S, const Epi& E, int wave0) {
    const int tid = ltid(wave0), wid = __builtin_amdgcn_readfirstlane(tid >> 6), lane = tid & 63, wr = wid >> 2, wc = wid & 3, fr = lane & 15, fq = lane >> 4;
    const int K = g.K, nt = K / BK;
    unsigned voffA[2], voffB[2];
#pragma unroll
    for (int i = 0; i < 2; ++i) { int Rr, C; stage_rc(tid * 16 + i * 8192, Rr, C); const int Rb = Epi::PERM ? ((Rr & ~31) + perm32(Rr & 31)) : Rr;
        voffA[i] = (unsigned)(Rr * g.lda + C) * 2u; voffB[i] = (unsigned)(Rb * g.ldb + C) * 2u; }
    const size_t kstep = (size_t)(BK * 2);
    const size_t hstepA = (size_t)HALF * g.lda * 2, hstepB = (size_t)HALF * g.ldb * 2;
    const unsigned ldsw = (unsigned)wid * 1024u;
    const int aoff = lds_byte(wr * 64 + fr, fq * 8), boff = lds_byte(wc * 32 + fr, fq * 8);
#define PG8_SA(b, h) (((b) * 2 + (h)) * HTB)
#define PG8_SB(b, h) ((4 + (b) * 2 + (h)) * HTB)
#define PG8_STAGE(bufoff, gbase, voff) do { _Pragma("unroll") for (int _i = 0; _i < 2; ++_i) \
        __builtin_amdgcn_global_load_lds((const unsigned*)((const char*)(gbase) + (voff)[_i]), (PG8_LAS unsigned*)(lds + (bufoff) + ldsw + _i * 8192), 16, 0, 0); } while (0)
#define PG8_LDA(dst, b, h) do { _Pragma("unroll") for (int m = 0; m < 4; ++m) _Pragma("unroll") for (int k = 0; k < 2; ++k) dst[m][k] = *(const PG8_LAS bf16x8*)(lds + PG8_SA(b, h) + aoff + m * 2048 + k * 1024); } while (0)
#define PG8_LDB(dst, b, h) do { _Pragma("unroll") for (int n = 0; n < 2; ++n) _Pragma("unroll") for (int k = 0; k < 2; ++k) dst[n][k] = *(const PG8_LAS bf16x8*)(lds + PG8_SB(b, h) + boff + n * 2048 + k * 1024); } while (0)
#define PG8_MMA(ai, bj, At, Bt) do { __builtin_amdgcn_s_setprio(1); _Pragma("unroll") for (int m = 0; m < 4; ++m) _Pragma("unroll") for (int n = 0; n < 2; ++n) _Pragma("unroll") for (int k = 0; k < 2; ++k) \
        acc[ai][bj][m][n] = __builtin_amdgcn_mfma_f32_16x16x32_bf16(Bt[n][k], At[m][k], acc[ai][bj][m][n], 0, 0, 0); __builtin_amdgcn_s_setprio(0); } while (0)
#define PG8_WAIT_V(n) asm volatile("s_waitcnt vmcnt(" #n ")" ::: "memory")
#define PG8_WAIT_L(n) asm volatile("s_waitcnt lgkmcnt(" #n ")" ::: "memory")
#define PG8_BAR __builtin_amdgcn_s_barrier()
#define PG8_SCHED __builtin_amdgcn_sched_barrier(0)
    Unit cur, nxt; int ui = 0;
    cur.nt = 0;
    if (!S.next(0, cur)) return;
    f32x4 acc[2][2][4][2];
#pragma unroll
    for (int a = 0; a < 2; ++a)
#pragma unroll
        for (int b = 0; b < 2; ++b)
#pragma unroll
            for (int m = 0; m < 4; ++m)
#pragma unroll
                for (int n = 0; n < 2; ++n) acc[a][b][m][n] = (f32x4){0.f, 0.f, 0.f, 0.f};
    bf16x8 At[4][2], B0[2][2], B1[2][2];
    const char* cA = cur.a; const char* cB = cur.b;
    if constexpr (SP2) {
        PG8_STAGE(PG8_SB(0, 0), cB, voffB); PG8_STAGE(PG8_SB(0, 1), cB + hstepB, voffB); PG8_STAGE(PG8_SA(0, 0), cA, voffA); PG8_STAGE(PG8_SA(0, 1), cA + hstepA, voffA);
        if (wr == 1) PG8_BAR;
        PG8_WAIT_V(2); PG8_BAR;
        PG8_STAGE(PG8_SB(1, 0), cB + kstep, voffB); PG8_STAGE(PG8_SA(1, 0), cA + kstep, voffA); PG8_STAGE(PG8_SB(1, 1), cB + hstepB + kstep, voffB);
        PG8_WAIT_V(6); PG8_BAR;
    } else {
        PG8_STAGE(PG8_SB(0, 0), cB, voffB); PG8_STAGE(PG8_SA(0, 0), cA, voffA); PG8_STAGE(PG8_SB(0, 1), cB + hstepB, voffB); PG8_STAGE(PG8_SA(0, 1), cA + hstepA, voffA);
        if (wr == 1) PG8_BAR;
        PG8_WAIT_V(4); PG8_BAR;
        PG8_STAGE(PG8_SB(1, 0), cB + kstep, voffB); PG8_STAGE(PG8_SA(1, 0), cA + kstep, voffA); PG8_STAGE(PG8_SB(1, 1), cB + hstepB + kstep, voffB);
        PG8_WAIT_V(6); PG8_BAR;
    }
    for (;;) {
        nxt.nt = 0; const bool has_next = S.next(ui + 1, nxt);
        const int ntc = cur.nt ? cur.nt : nt;
        const char* nA = has_next ? nxt.a : cA; const char* nB = has_next ? nxt.b : cB;
        for (int t = 0; t < ntc; t += 2) {
            const bool last = (t == ntc - 2);
            const char* a1 = cA + (size_t)(t + 1) * kstep;
            const char* a2 = last ? nA : cA + (size_t)(t + 2) * kstep; const char* b2 = last ? nB : cB + (size_t)(t + 2) * kstep;
            const char* a3 = a2 + kstep; const char* b3 = b2 + kstep;
            if constexpr (SP2) {
            PG8_LDB(B0, 0, 0); PG8_LDB(B1, 0, 1); PG8_SCHED; PG8_LDA(At, 0, 0); PG8_STAGE(PG8_SA(1, 1), a1 + hstepA, voffA);
            PG8_WAIT_V(8); PG8_WAIT_L(0); PG8_BAR; PG8_MMA(0, 0, At, B0); PG8_MMA(0, 1, At, B1); PG8_BAR; PG8_SCHED;
            PG8_LDA(At, 0, 1); PG8_STAGE(PG8_SB(0, 0), b2, voffB); PG8_STAGE(PG8_SB(0, 1), b2 + hstepB, voffB); PG8_STAGE(PG8_SA(0, 0), a2, voffA);
            PG8_WAIT_V(8); PG8_WAIT_L(0); PG8_BAR; PG8_MMA(1, 0, At, B0); PG8_MMA(1, 1, At, B1); PG8_BAR; PG8_SCHED;
            PG8_LDB(B0, 1, 0); PG8_LDB(B1, 1, 1); PG8_SCHED; PG8_LDA(At, 1, 0); PG8_STAGE(PG8_SA(0, 1), a2 + hstepA, voffA);
            PG8_WAIT_V(8); PG8_WAIT_L(0); PG8_BAR; PG8_MMA(0, 0, At, B0); PG8_MMA(0, 1, At, B1); PG8_BAR; PG8_SCHED;
            PG8_LDA(At, 1, 1); PG8_STAGE(PG8_SB(1, 0), b3, voffB); PG8_STAGE(PG8_SB(1, 1), b3 + hstepB, voffB); PG8_STAGE(PG8_SA(1, 0), a3, voffA);
            PG8_WAIT_V(8); PG8_WAIT_L(0); PG8_BAR; PG8_MMA(1, 0, At, B0); PG8_MMA(1, 1, At, B1); PG8_BAR; PG8_SCHED;
            } else {
            PG8_LDB(B0, 0, 0); PG8_SCHED; PG8_LDA(At, 0, 0); PG8_STAGE(PG8_SA(1, 1), a1 + hstepA, voffA);
            PG8_WAIT_L(8); PG8_BAR; PG8_WAIT_L(0); PG8_MMA(0, 0, At, B0); PG8_BAR; PG8_SCHED;
            PG8_LDB(B1, 0, 1); PG8_STAGE(PG8_SB(0, 0), b2, voffB);
            PG8_BAR; PG8_WAIT_L(0); PG8_MMA(0, 1, At, B1); PG8_BAR;
            PG8_LDA(At, 0, 1); PG8_STAGE(PG8_SA(0, 0), a2, voffA);
            PG8_BAR; PG8_WAIT_L(0); PG8_MMA(1, 0, At, B0); PG8_BAR; PG8_SCHED;
            PG8_STAGE(PG8_SB(0, 1), b2 + hstepB, voffB);
            PG8_WAIT_V(6); PG8_BAR; PG8_MMA(1, 1, At, B1); PG8_BAR;
            PG8_LDB(B0, 1, 0); PG8_SCHED; PG8_LDA(At, 1, 0); PG8_STAGE(PG8_SA(0, 1), a2 + hstepA, voffA);
            PG8_WAIT_L(8); PG8_BAR; PG8_WAIT_L(0); PG8_MMA(0, 0, At, B0); PG8_BAR; PG8_SCHED;
            PG8_LDB(B1, 1, 1); PG8_STAGE(PG8_SB(1, 0), b3, voffB);
            PG8_BAR; PG8_WAIT_L(0); PG8_MMA(0, 1, At, B1); PG8_BAR;
            PG8_LDA(At, 1, 1); PG8_STAGE(PG8_SA(1, 0), a3, voffA);
            PG8_BAR; PG8_WAIT_L(0); PG8_MMA(1, 0, At, B0); PG8_BAR; PG8_SCHED;
            PG8_STAGE(PG8_SB(1, 1), b3 + hstepB, voffB);
            PG8_WAIT_V(6); PG8_BAR; PG8_MMA(1, 1, At, B1); PG8_BAR;
            }
        }
        if constexpr (ALIGN_EPI) { if (wr == 0) PG8_BAR; }
        E(acc, cur, wr, wc, fr, fq);
        if (!has_next) break;
#pragma unroll
        for (int a = 0; a < 2; ++a)
#pragma unroll
            for (int b = 0; b < 2; ++b)
#pragma unroll
                for (int m = 0; m < 4; ++m)
#pragma unroll
                    for (int n = 0; n < 2; ++n) acc[a][b][m][n] = (f32x4){0.f, 0.f, 0.f, 0.f};
        cur = nxt; cA = nA; cB = nB; ++ui;
        if constexpr (ALIGN_EPI) { if (wr == 1) PG8_BAR; }
    }
    PG8_WAIT_V(0);
    if constexpr (!ALIGN_EPI) { if (wr == 0) PG8_BAR; }
    PG8_BAR;
#undef PG8_SA
#undef PG8_SB
#undef PG8_STAGE
#undef PG8_LDA
#undef PG8_LDB
#undef PG8_MMA
#undef PG8_WAIT_V
#undef PG8_WAIT_L
#undef PG8_BAR
#undef PG8_SCHED
}

__device__ __forceinline__ u32x4 pack_acc(const f32x4 v0, const f32x4 v1) { u32x4 w; w.x = cvt_pk_bf16(v0[0], v0[1]); w.y = cvt_pk_bf16(v0[2], v0[3]); w.z = cvt_pk_bf16(v1[0], v1[1]); w.w = cvt_pk_bf16(v1[2], v1[3]); return w; }

struct EpiBf16 {
    static constexpr bool PERM = true;
    bf16_t* O; int ld; bf16_t* O2 = nullptr; int rowsub = 0;
    __device__ __forceinline__ void operator()(const Acc& acc, const Unit& u, int wr, int wc, int fr, int fq) const {
        bf16_t* base = (u.z ? O2 - (size_t)rowsub * ld : O) + (size_t)(u.pm * BM + wr * 64 + fr) * ld + u.pn * BM + wc * 32 + 8 * fq;
#pragma unroll
        for (int ai = 0; ai < 2; ++ai)
#pragma unroll
            for (int m = 0; m < 4; ++m) { bf16_t* rowp = base + (size_t)(ai * HALF + m * 16) * ld;
#pragma unroll
                for (int bj = 0; bj < 2; ++bj) *(u32x4*)(rowp + bj * HALF) = pack_acc(acc[ai][bj][m][0], acc[ai][bj][m][1]); }
    }
};
struct EpiF32 {
    static constexpr bool PERM = false;
    float* C; int ld;
    __device__ __forceinline__ void operator()(const Acc& acc, const Unit& u, int wr, int wc, int fr, int fq) const {
        float* base = C + (size_t)(u.pm * BM + wr * 64 + fr) * ld + u.pn * BM + wc * 32 + 4 * fq;
#pragma unroll
        for (int ai = 0; ai < 2; ++ai)
#pragma unroll
            for (int m = 0; m < 4; ++m) { float* rowp = base + (size_t)(ai * HALF + m * 16) * ld;
#pragma unroll
                for (int bj = 0; bj < 2; ++bj)
#pragma unroll
                    for (int n = 0; n < 2; ++n) *(f32x4*)(rowp + bj * HALF + n * 16) = acc[ai][bj][m][n]; }
    }
};
struct EpiBf16z {
    static constexpr bool PERM = true;
    unsigned char* ws;
    __device__ __forceinline__ void operator()(const Acc& acc, const Unit& u, int wr, int wc, int fr, int fq) const {
        bf16_t* base = (bf16_t*)(ws + (u.z ? WS_OINTRA : WS_YOUT)) + (size_t)(u.pm * BM + wr * 64 + fr) * 2048 + u.pn * BM + wc * 32 + 8 * fq;
#pragma unroll
        for (int ai = 0; ai < 2; ++ai)
#pragma unroll
            for (int m = 0; m < 4; ++m) { bf16_t* rowp = base + (size_t)(ai * HALF + m * 16) * 2048;
#pragma unroll
                for (int bj = 0; bj < 2; ++bj) *(u32x4*)(rowp + bj * HALF) = pack_acc(acc[ai][bj][m][0], acc[ai][bj][m][1]); }
    }
};
__device__ __forceinline__ float dpp_ror1(float x) { return __int_as_float(__builtin_amdgcn_update_dpp(0, __float_as_int(x), 0x121, 0xf, 0xf, false)); }
__device__ __forceinline__ float dpp_rol1(float x) { return __int_as_float(__builtin_amdgcn_update_dpp(0, __float_as_int(x), 0x12f, 0xf, 0xf, false)); }
struct EpiFfn {
    static constexpr bool PERM = true, CARRY = false;
    bf16_t* act; bf16_t* sg; bf16_t* sv; const float* cw; const float* cb; bf16_t* upq;
    __device__ __forceinline__ void operator()(const Acc& acc, const Unit& u, int wr, int wc, int fr, int fq) const {
        if (u.z) {
            bf16_t* base = upq + (size_t)(u.pm * BM + wr * 64 + fr) * 256 + wc * 32 + 8 * fq;
#pragma unroll
            for (int ai = 0; ai < 2; ++ai)
#pragma unroll
                for (int m = 0; m < 4; ++m) { bf16_t* rowp = base + (size_t)(ai * HALF + m * 16) * 256;
#pragma unroll
                    for (int bj = 0; bj < 2; ++bj) *(u32x4*)(rowp + bj * HALF) = pack_acc(acc[ai][bj][m][0], acc[ai][bj][m][1]); }
            return;
        }
        const int chb = u.pn * 128 + wc * 32 + 8 * fq;
        float w0[8], w1[8], w2[8], bb[8];
#pragma unroll
        for (int c = 0; c < 8; ++c) { w0[c] = cw[chb + c]; w1[c] = cw[DFF + chb + c]; w2[c] = cw[2 * DFF + chb + c]; bb[c] = cb[chb + c]; }
        const bool f0 = fr == 0, f15 = fr == 15;
#pragma unroll
        for (int ai = 0; ai < 2; ++ai) {
            const int rowb = u.pm * BM + ai * HALF + wr * 64;
#pragma unroll
            for (int m = 0; m < 4; ++m) { float o[8];
#pragma unroll
                for (int c = 0; c < 8; ++c) { const int n = c >> 2, j = c & 3; const float g = acc[ai][1][m][n][j];
                    const float sendp = f15 ? (m > 0 ? acc[ai][1][m > 0 ? m - 1 : 0][n][j] : 0.f) : g, sendn = f0 ? (m < 3 ? acc[ai][1][m < 3 ? m + 1 : 3][n][j] : 0.f) : g;
                    const float prev = dpp_ror1(sendp), next = dpp_rol1(sendn);
                    const float gt = w0[c] * prev + w1[c] * g + w2[c] * next + bb[c]; o[c] = gelu_tanh_f(gt) * acc[ai][0][m][n][j]; }
                const bool bnd = (m == 0 && f0) || (m == 3 && f15);
                if (!bnd) *(u32x4*)(act + (size_t)(rowb + 16 * m + fr) * DFF + chb) = pack8(o); }
            const int span = rowb >> 6;
            if (fr < 2) { *(u32x4*)(sg + (size_t)(span * 4 + fr) * DFF + chb) = pack_acc(acc[ai][1][0][0], acc[ai][1][0][1]); if (f0) *(u32x4*)(sv + (size_t)(span * 2) * DFF + chb) = pack_acc(acc[ai][0][0][0], acc[ai][0][0][1]); }
            if (fr >= 14) { *(u32x4*)(sg + (size_t)(span * 4 + fr - 12) * DFF + chb) = pack_acc(acc[ai][1][3][0], acc[ai][1][3][1]); if (f15) *(u32x4*)(sv + (size_t)(span * 2 + 1) * DFF + chb) = pack_acc(acc[ai][0][3][0], acc[ai][0][3][1]); }
        }
    }
};
struct EpiIn {
    static constexpr bool PERM = true;
    unsigned char* ws; float* out; int layer;
    __device__ __forceinline__ void operator()(const Acc& acc, const Unit& u, int wr, int wc, int fr, int fq) const {
        const int pm = u.pm, pn = u.pn;
        if (u.z == 1) {
            bf16_t* base = (bf16_t*)(ws + WS_ZVT) + (size_t)(pm * BM + wr * 64 + fr) * R + pn * BM + wc * 32 + 8 * fq;
#pragma unroll
            for (int ai = 0; ai < 2; ++ai)
#pragma unroll
                for (int m = 0; m < 4; ++m) { bf16_t* rowp = base + (size_t)(ai * HALF + m * 16) * R;
#pragma unroll
                    for (int bj = 0; bj < 2; ++bj) *(u32x4*)(rowp + bj * HALF) = pack_acc(acc[ai][bj][m][0], acc[ai][bj][m][1]); }
            return;
        }
        if (u.z >= 2) {
            if (wc == 0) {
                float* p0 = (float*)(ws + WS_ZAP) + (size_t)(u.z - 2) * R * 32 + (size_t)(pm * BM + wr * 64 + fr) * 32 + 8 * fq;
#pragma unroll
                for (int ai = 0; ai < 2; ++ai)
#pragma unroll
                    for (int m = 0; m < 4; ++m) { float* p = p0 + (size_t)(ai * HALF + m * 16) * 32;
                        *(f32x4*)p = acc[ai][0][m][0]; *(f32x4*)(p + 4) = acc[ai][0][m][1]; }
            }
            return;
        }
        size_t boff; int ld, c0, rowadd = 0; bool f32o = false, act = false;
        if (pn < 4) { boff = WS_ZQ; ld = 1024; c0 = pn * 256; }
        else if (pn < 8) { boff = WS_ZK; ld = 1024; c0 = (pn - 4) * 256; }
        else if (pn < 16) { boff = WS_ZG; ld = 2048; c0 = (pn - 8) * 256; }
        else if (pn < 24) { boff = WS_DQ; ld = 2048; c0 = (pn - 16) * 256; }
        else if (pn < 40) { const bool isv = pn >= 32; boff = isv ? WS_DV : WS_DK; ld = 2048; c0 = (pn - (isv ? 32 : 24)) * 256;
            if (pm >= 32) rowadd = 256 * (((pm - 32) >> 3) + 1); else f32o = true; }
        else if (pn < 48) { const int cc = (pn - 40) * 256; boff = WS_ZF + (size_t)(cc >> 9) * R * 512 * 2; ld = 512; c0 = cc & 511; }
        else { boff = WS_GATE; ld = 6144; c0 = (pn - 48) * 256; act = true; }
        const int rin0 = wr * 64 + fr, cin = wc * 32 + 8 * fq;
        bf16_t* base = (bf16_t*)(ws + boff) + (size_t)(pm * BM + rowadd + rin0) * ld + c0 + cin;
#pragma unroll
        for (int ai = 0; ai < 2; ++ai)
#pragma unroll
            for (int m = 0; m < 4; ++m) { bf16_t* rowp = base + (size_t)(ai * HALF + m * 16) * ld;
#pragma unroll
                for (int bj = 0; bj < 2; ++bj) { f32x4 v0 = acc[ai][bj][m][0], v1 = acc[ai][bj][m][1];
                    if (act) {
#pragma unroll
                        for (int j = 0; j < 4; ++j) { v0[j] = sigmoid_f(v0[j]); v1[j] = sigmoid_f(v1[j]); } }
                    *(u32x4*)(rowp + bj * HALF) = pack_acc(v0, v1); } }
        if (f32o) {
            float* fb = out + (pn >= 32 ? O_NV : O_NK) + ((size_t)(pm * 2 + layer) * 256 + rin0) * 2048 + c0 + cin;
#pragma unroll
            for (int ai = 0; ai < 2; ++ai)
#pragma unroll
                for (int m = 0; m < 4; ++m) { float* fp = fb + (size_t)(ai * HALF + m * 16) * 2048;
#pragma unroll
                    for (int bj = 0; bj < 2; ++bj) { __builtin_nontemporal_store(acc[ai][bj][m][0], (f32x4*)(fp + bj * HALF)); __builtin_nontemporal_store(acc[ai][bj][m][1], (f32x4*)(fp + bj * HALF + 4)); } }
        }
    }
};
struct EpiBr {
    static constexpr bool PERM = true, CARRY = false;
    unsigned char* pbase; const bf16_t* gate;
    __device__ __forceinline__ void operator()(const Acc& acc, const Unit& u, int wr, int wc, int fr, int fq) const {
        const int zb = u.z & 3, kh = u.z >> 2;
        bf16_t* P = kh ? (bf16_t*)(pbase - WS_DQ + WS_QIN) - (size_t)RC * 2048 : (bf16_t*)(pbase + (zb == 0 ? (size_t)0 : (zb == 1 ? (WS_DK - WS_DQ) : (WS_DV - WS_DQ))));
        const int row0 = u.pm * BM + wr * 64 + fr, col0 = u.pn * BM + wc * 32 + 8 * fq;
        u32x4 gw[2][4][2];
#pragma unroll
        for (int ai = 0; ai < 2; ++ai)
#pragma unroll
            for (int m = 0; m < 4; ++m)
#pragma unroll
                for (int bj = 0; bj < 2; ++bj) gw[ai][m][bj] = *(const u32x4*)(gate + (size_t)(row0 + ai * HALF + m * 16) * 6144 + zb * 2048 + col0 + bj * HALF);
#pragma unroll
        for (int ai = 0; ai < 2; ++ai)
#pragma unroll
            for (int m = 0; m < 4; ++m) { const int row = row0 + ai * HALF + m * 16;
#pragma unroll
                for (int bj = 0; bj < 2; ++bj) { const int col = col0 + bj * HALF;
                    float gv[8]; unpack8(gw[ai][m][bj], gv);
                    f32x4 v0 = acc[ai][bj][m][0], v1 = acc[ai][bj][m][1];
#pragma unroll
                    for (int j = 0; j < 4; ++j) { v0[j] *= gv[j]; v1[j] *= gv[4 + j]; }
                    *(u32x4*)(P + (size_t)row * 2048 + col) = pack_acc(v0, v1); } }
    }
};
struct EpiY {
    static constexpr bool PERM = true;
    bf16_t* Y;
    __device__ __forceinline__ void operator()(const Acc& acc, const Unit& u, int wr, int wc, int fr, int fq) const {
        const int cs = u.pm >> 1, ch0 = (u.pm & 1) * 256, g = u.z;
        size_t off;
        if (u.pn < 32) off = (size_t)u.pn * 512 + cs * 256; else { const int bb = (u.pn - 32) >> 3, lt = (u.pn - 32) & 7; off = 16384 + (size_t)bb * 4096 + cs * 2048 + lt * 256; }
        bf16_t* base = Y + (size_t)(g * 512 + ch0 + wr * 64 + fr) * 24576 + off + wc * 32 + 8 * fq;
#pragma unroll
        for (int ai = 0; ai < 2; ++ai)
#pragma unroll
            for (int m = 0; m < 4; ++m) { bf16_t* rowp = base + (size_t)(ai * HALF + m * 16) * 24576;
#pragma unroll
                for (int bj = 0; bj < 2; ++bj) *(u32x4*)(rowp + bj * HALF) = pack_acc(acc[ai][bj][m][0], acc[ai][bj][m][1]); }
    }
};
struct EpiZaQ {
    static constexpr bool PERM = true;
    unsigned char* ws;
    __device__ __forceinline__ void operator()(const Acc& acc, const Unit& u, int wr, int wc, int fr, int fq) const {
        if (wc != 0) return;
        float* p0 = (float*)(ws + WS_ZAP) + (size_t)u.z * R * 32 + (size_t)(u.pm * BM + wr * 64 + fr) * 32 + 8 * fq;
#pragma unroll
        for (int ai = 0; ai < 2; ++ai)
#pragma unroll
            for (int m = 0; m < 4; ++m) { float* p = p0 + (size_t)(ai * HALF + m * 16) * 32;
                *(f32x4*)p = acc[ai][0][m][0]; *(f32x4*)(p + 4) = acc[ai][0][m][1]; }
    }
};
}

namespace attn {
constexpr int DH = 128, NW = 8, QBLK = 32, KVBLK = 64;
constexpr float SCALE = 0.088388347648318440f;
constexpr float THR = 8.f;
constexpr size_t SHM_V = KVBLK * DH * 2, SHM_K = KVBLK * DH * 2, SHM_ATTN = 2 * SHM_V + 2 * SHM_K + NW * 64 * 4;
#define KSWZ(row, colB) ((row) * 256 + ((colB) ^ (((row) & 7) << 4)))
#define SBAR() __builtin_amdgcn_sched_barrier(0)
__device__ __forceinline__ int crow(int r, int hi) { return (r & 3) + 8 * (r >> 2) + 4 * hi; }
__device__ __forceinline__ unsigned cvtpk(float lo, float hi) { unsigned r; asm volatile("v_cvt_pk_bf16_f32 %0, %1, %2" : "=v"(r) : "v"(lo), "v"(hi)); return r; }
__device__ __forceinline__ void partialSM(f32x16& p0, f32x16& p1, float& m_reg, float& mn, float& alpha) {
  constexpr float C = SCALE * 1.4426950408889634f;
  float pmax = p0[0];
#pragma unroll
  for (int r = 1; r < 16; ++r) pmax = fmaxf(pmax, p0[r]);
#pragma unroll
  for (int r = 0; r < 16; ++r) pmax = fmaxf(pmax, p1[r]);
  { auto rr = __builtin_amdgcn_permlane32_swap(__float_as_uint(pmax), __float_as_uint(pmax), false, false);
    pmax = fmaxf(__uint_as_float(rr[0]), __uint_as_float(rr[1])); }
  if (__builtin_expect(__all(pmax - m_reg <= THR / SCALE), 1)) { mn = m_reg; alpha = 1.f; }
  else { mn = fmaxf(m_reg, pmax); alpha = __builtin_amdgcn_exp2f((m_reg - mn) * C); m_reg = mn; }
  float mnC = -mn * C;
#pragma unroll
  for (int r = 0; r < 16; ++r) p0[r] = fmaf(p0[r], C, mnC);
#pragma unroll
  for (int r = 0; r < 16; ++r) p1[r] = fmaf(p1[r], C, mnC);
#pragma unroll
  for (int r = 0; r < 16; ++r) p0[r] = __builtin_amdgcn_exp2f(p0[r]);
}
__device__ __forceinline__ void finishSM(f32x16& p0, f32x16& p1, float alpha, float& l_reg, bf16x8& pa0, bf16x8& pa1, bf16x8& pa2, bf16x8& pa3) {
#pragma unroll
  for (int r = 0; r < 16; ++r) p1[r] = __builtin_amdgcn_exp2f(p1[r]);
  float ps = 0;
#pragma unroll
  for (int r = 0; r < 16; ++r) ps += p0[r];
#pragma unroll
  for (int r = 0; r < 16; ++r) ps += p1[r];
  { auto rr = __builtin_amdgcn_permlane32_swap(__float_as_uint(ps), __float_as_uint(ps), false, false);
    ps = __uint_as_float(rr[0]) + __uint_as_float(rr[1]); }
  l_reg = l_reg * alpha + ps;
#define PK4(P, BASE, OUT) do { unsigned a0 = cvtpk(P[BASE + 0], P[BASE + 1]), a1 = cvtpk(P[BASE + 2], P[BASE + 3]);   \
    unsigned b0 = cvtpk(P[BASE + 4], P[BASE + 5]), b1 = cvtpk(P[BASE + 6], P[BASE + 7]);                              \
    auto r0 = __builtin_amdgcn_permlane32_swap(a0, b0, false, false); auto r1 = __builtin_amdgcn_permlane32_swap(a1, b1, false, false); \
    u32x4 w = {r0[0], r1[0], r0[1], r1[1]}; OUT = *reinterpret_cast<bf16x8*>(&w); } while (0)
  PK4(p0, 0, pa0); PK4(p0, 8, pa1); PK4(p1, 0, pa2); PK4(p1, 8, pa3);
#undef PK4
}
__device__ __forceinline__ void qkt(f32x16& p0, f32x16& p1, const bf16_t* Ks, const bf16x8* qr, int r32, int hi) {
  p0 = f32x16{}; p1 = f32x16{};
#pragma unroll
  for (int d0 = 0; d0 < 8; ++d0) { int cb = (d0 * 16 + hi * 8) * 2;
    bf16x8 b0 = *reinterpret_cast<const bf16x8*>((const char*)Ks + KSWZ(r32, cb));
    bf16x8 b1 = *reinterpret_cast<const bf16x8*>((const char*)Ks + KSWZ(32 + r32, cb));
    p0 = __builtin_amdgcn_mfma_f32_32x32x16_bf16(b0, qr[d0], p0, 0, 0, 0);
    p1 = __builtin_amdgcn_mfma_f32_32x32x16_bf16(b1, qr[d0], p1, 0, 0, 0); }
}
__device__ __forceinline__ int v_st(int k, int c) { const int kk = (k & ~0xC) | ((k & 4) << 1) | ((k & 8) >> 1); return ((kk >> 3) * 4 + (c >> 5)) * 512 + ((kk & 7) * 32 + (c & 31)) * 2; }
__device__ __forceinline__ int v_rd_base(int lane) { return ((lane & 3) << 3) | (((lane >> 2) & 3) << 6) | (((lane >> 4) & 1) << 5) | (((lane >> 5) & 1) << 8); }
constexpr int v_rd_off(int d0, int ks, int half) { return d0 * 512 + ks * 4096 + half * 2048; }
template <int OFF> __device__ __forceinline__ s16x4 tr_read(int vb) {
  s16x4 r; asm volatile("ds_read_b64_tr_b16 %0, %1 offset:%2" : "=&v"(r) : "v"(vb), "i"(OFF) : "memory"); return r;
}
template <int D0> __device__ __forceinline__ void pv_one(f32x16& od, int vb, bf16x8 pa0, bf16x8 pa1, bf16x8 pa2, bf16x8 pa3) {
  const s16x4 l0 = tr_read<v_rd_off(D0, 0, 0)>(vb), h0 = tr_read<v_rd_off(D0, 0, 1)>(vb), l1 = tr_read<v_rd_off(D0, 1, 0)>(vb), h1 = tr_read<v_rd_off(D0, 1, 1)>(vb);
  const s16x4 l2 = tr_read<v_rd_off(D0, 2, 0)>(vb), h2 = tr_read<v_rd_off(D0, 2, 1)>(vb), l3 = tr_read<v_rd_off(D0, 3, 0)>(vb), h3 = tr_read<v_rd_off(D0, 3, 1)>(vb);
  asm volatile("s_waitcnt lgkmcnt(0)" ::: "memory"); SBAR();
#define PK(L, H) (bf16x8){L[0], L[1], L[2], L[3], H[0], H[1], H[2], H[3]}
  od = __builtin_amdgcn_mfma_f32_32x32x16_bf16(pa0, PK(l0, h0), od, 0, 0, 0);
  od = __builtin_amdgcn_mfma_f32_32x32x16_bf16(pa1, PK(l1, h1), od, 0, 0, 0);
  od = __builtin_amdgcn_mfma_f32_32x32x16_bf16(pa2, PK(l2, h2), od, 0, 0, 0);
  od = __builtin_amdgcn_mfma_f32_32x32x16_bf16(pa3, PK(l3, h3), od, 0, 0, 0);
#undef PK
}
__device__ __forceinline__ void pv_d0(f32x16* o, int vb, bf16x8 pa0, bf16x8 pa1, bf16x8 pa2, bf16x8 pa3) {
  pv_one<0>(o[0], vb, pa0, pa1, pa2, pa3); pv_one<1>(o[1], vb, pa0, pa1, pa2, pa3); pv_one<2>(o[2], vb, pa0, pa1, pa2, pa3); pv_one<3>(o[3], vb, pa0, pa1, pa2, pa3);
}
template <int LDQ, int LDK, int LDO>
__device__ __forceinline__ void attn_dense_body(const bf16_t* __restrict__ Qb, const bf16_t* __restrict__ Kh, const bf16_t* __restrict__ Vh, bf16_t* __restrict__ Ob, int seq, char* lds, int wave0) {
  const int tid = ltid(wave0), wid = tid >> 6, lane = tid & 63, r32 = lane & 31, hi = lane >> 5;
  bf16_t* V_lds = (bf16_t*)lds; bf16_t* K_lds = (bf16_t*)(lds + 2 * SHM_V);
  float* ws = (float*)(lds + 2 * SHM_V + 2 * SHM_K) + wid * 64; float* li_l = ws; float* al_l = ws + 32;
  float m_reg = -1e30f, l_reg = 0; f32x16 o[4] = {}; bf16x8 qr[8];
  const bf16_t* Qw = Qb + (long)(wid * QBLK + r32) * LDQ + hi * 8;
#pragma unroll
  for (int d0 = 0; d0 < 8; ++d0) qr[d0] = *reinterpret_cast<const bf16x8*>(Qw + d0 * 16);
  const int sr = tid >> 4, sc = (tid & 15) * 8, vst0 = v_st(sr, sc), vst1 = v_st(32 + sr, sc);
  const int vb0 = (int)(uintptr_t)V_lds + v_rd_base(lane);
  struct { bf16x8 vs0, vs1, ks0, ks1; } sr_[2];
#define LD8(p) (*reinterpret_cast<const bf16x8*>(p))
#define SLOAD(i, k0) do { sr_[i].vs0 = LD8(&Vh[(long)((k0) + sr) * LDK + sc]); sr_[i].vs1 = LD8(&Vh[(long)((k0) + 32 + sr) * LDK + sc]); \
    sr_[i].ks0 = LD8(&Kh[(long)((k0) + sr) * LDK + sc]); sr_[i].ks1 = LD8(&Kh[(long)((k0) + 32 + sr) * LDK + sc]); } while (0)
#define SWRITE(b, i) do { *(bf16x8*)((char*)V_lds + (b) * SHM_V + vst0) = sr_[i].vs0;          \
    *(bf16x8*)((char*)V_lds + (b) * SHM_V + vst1) = sr_[i].vs1; int kc = sc * 2;               \
    *(bf16x8*)((char*)K_lds + (b) * SHM_K + KSWZ(sr, kc)) = sr_[i].ks0;                       \
    *(bf16x8*)((char*)K_lds + (b) * SHM_K + KSWZ(32 + sr, kc)) = sr_[i].ks1; } while (0)
#define SWAIT() asm volatile("s_waitcnt vmcnt(4)" ::: "memory")
#define RESC(a) do { if (__any((a) < 1.f)) { if (hi == 0) al_l[r32] = (a); asm volatile("s_waitcnt lgkmcnt(0)" ::: "memory"); \
    _Pragma("unroll") for (int d = 0; d < 4; ++d) _Pragma("unroll") for (int r = 0; r < 16; ++r) o[d][r] *= al_l[crow(r, hi)]; } } while (0)
  f32x16 pA0, pA1, pB0, pB1; float mnA, mnB, alA, alB; bf16x8 pa0, pa1, pa2, pa3; const int NT = seq / KVBLK;
  constexpr int SE = 0, SO = 1;
  SLOAD(SE, 0); asm volatile("s_waitcnt vmcnt(0)" ::: "memory"); SWRITE(0, SE); __syncthreads();
  qkt(pA0, pA1, K_lds, qr, r32, hi); partialSM(pA0, pA1, m_reg, mnA, alA);
  SLOAD(SO, KVBLK); if (2 < NT) SLOAD(SE, 2 * KVBLK);
  SWAIT(); SWRITE(1, SO); __syncthreads();
  for (int j = 1; j + 1 < NT; j += 2) {
    SBAR(); qkt(pB0, pB1, (bf16_t*)((char*)K_lds + SHM_K), qr, r32, hi);
    finishSM(pA0, pA1, alA, l_reg, pa0, pa1, pa2, pa3); SBAR();
    SLOAD(SO, (j + 2) * KVBLK); SBAR();
    pv_d0(o, vb0, pa0, pa1, pa2, pa3); partialSM(pB0, pB1, m_reg, mnB, alB);
    __syncthreads(); SWAIT(); SWRITE(0, SE);
    RESC(alB); __syncthreads();
    SBAR(); qkt(pA0, pA1, K_lds, qr, r32, hi);
    finishSM(pB0, pB1, alB, l_reg, pa0, pa1, pa2, pa3); SBAR();
    if (j + 3 < NT) SLOAD(SE, (j + 3) * KVBLK); SBAR();
    pv_d0(o, vb0 + (int)SHM_V, pa0, pa1, pa2, pa3); partialSM(pA0, pA1, m_reg, mnA, alA);
    __syncthreads(); SWAIT(); SWRITE(1, SO);
    RESC(alA); __syncthreads();
  }
  SBAR(); qkt(pB0, pB1, (bf16_t*)((char*)K_lds + SHM_K), qr, r32, hi);
  finishSM(pA0, pA1, alA, l_reg, pa0, pa1, pa2, pa3); SBAR();
  pv_d0(o, vb0, pa0, pa1, pa2, pa3); partialSM(pB0, pB1, m_reg, mnB, alB);
  __syncthreads(); RESC(alB);
  finishSM(pB0, pB1, alB, l_reg, pa0, pa1, pa2, pa3); SBAR();
  pv_d0(o, vb0 + (int)SHM_V, pa0, pa1, pa2, pa3);
  if (hi == 0) li_l[r32] = l_reg; asm volatile("s_waitcnt lgkmcnt(0)" ::: "memory");
  float rli[16];
#pragma unroll
  for (int r = 0; r < 16; ++r) rli[r] = __builtin_amdgcn_rcpf(li_l[crow(r, hi)]);
  bf16_t* Ow = Ob + (long)(wid * QBLK) * LDO;
#pragma unroll
  for (int r = 0; r < 16; ++r) { int orow = crow(r, hi);
#pragma unroll
    for (int d0 = 0; d0 < 4; ++d0) Ow[(long)orow * LDO + d0 * 32 + r32] = (bf16_t)f2bf(o[d0][r] * rli[r]); }
#undef LD8
#undef SLOAD
#undef SWRITE
#undef SWAIT
#undef RESC
}
}

#define XB_TMO      128
#define XB_XCNT(j)  (256  + 64 * (j))
#define XB_XSUB(j)  (1280 + 64 * (j))
#define XB_XGEN(j)  (2304 + 64 * (j))
#define XB_TOP      3328
#define XB_TOPGEN   3392
#define XCD_BAR_WORDS 3456
#define XB_SPIN_CAP (1u << 18)
__device__ __forceinline__ unsigned xb_ld(unsigned* p)              { return __hip_atomic_load(p, __ATOMIC_RELAXED, __HIP_MEMORY_SCOPE_AGENT); }
__device__ __forceinline__ unsigned xb_add(unsigned* p, unsigned v) { return __hip_atomic_fetch_add(p, v, __ATOMIC_RELAXED, __HIP_MEMORY_SCOPE_AGENT); }
__device__ __forceinline__ unsigned xb_xcc_id() { return (unsigned)__builtin_amdgcn_s_getreg((3 << 11) | 20) & 0xFu; }
#define XB_SPIN(cond, bar) do { unsigned _sp = 0; while (cond) { __builtin_amdgcn_s_sleep(1); \
    if ((++_sp & 255u) == 0u) { if (xb_ld(&(bar)[XB_TMO])) break; if (_sp > XB_SPIN_CAP) { atomicAdd(&(bar)[XB_TMO], 1u); break; } } } } while (0)
struct XcdBarrier { unsigned* bar; unsigned x; volatile LAS unsigned* st; };
__device__ __forceinline__ XcdBarrier xcd_barrier_post(unsigned* bar, volatile LAS unsigned* st) {
    XcdBarrier b; b.bar = bar; b.x = xb_xcc_id(); b.st = st;
    if (threadIdx.x == 0) (void)xb_add(&bar[XB_XCNT(b.x)], 1u);
    return b;
}
__device__ __forceinline__ void xcd_barrier_complete(unsigned* bar, unsigned x, unsigned& nloc, unsigned& nx) {
    const unsigned G = gridDim.x * gridDim.y * gridDim.z;
    unsigned sum, cnt, mine, sp = 0u;
    for (;;) {
        sum = 0u; cnt = 0u; mine = 0u;
#pragma unroll
        for (unsigned j = 0; j < 16; ++j) { const unsigned c = xb_ld(&bar[XB_XCNT(j)]); sum += c; cnt += (c > 0u) ? 1u : 0u; mine = (j == x) ? c : mine; }
        if (sum == G) break;
        __builtin_amdgcn_s_sleep(1);
        if ((++sp & 255u) == 0u) { if (xb_ld(&bar[XB_TMO])) break; if (sp > XB_SPIN_CAP) { atomicAdd(&bar[XB_TMO], 1u); break; } }
    }
    nloc = mine > 0u ? mine : 1u; nx = cnt > 0u ? cnt : 1u;
}
__device__ __forceinline__ void xcd_barrier(const XcdBarrier& b) {
    asm volatile("s_waitcnt vmcnt(0)" ::: "memory");
    __syncthreads();
    if (threadIdx.x == 0) {
        GAS unsigned* barg = (GAS unsigned*)b.bar; asm volatile("" : "+s"(barg)); unsigned* bar = (unsigned*)barg;
        unsigned bx = b.x; asm volatile("" : "+s"(bx));
        __builtin_amdgcn_s_waitcnt(0);
        unsigned nloc = b.st[0], nx = b.st[1];
        if (nloc == 0u) { xcd_barrier_complete(bar, bx, nloc, nx); b.st[0] = nloc; b.st[1] = nx; }
        const unsigned old = xb_add(&bar[XB_XSUB(bx)], 1u);
        const unsigned gen = old / nloc;
        if (old + 1u == (gen + 1u) * nloc) {
            __builtin_amdgcn_fence(__ATOMIC_RELEASE, "agent");
            asm volatile("s_waitcnt vmcnt(0)" ::: "memory");
            const unsigned og = xb_add(&bar[XB_TOP], 1u);
            const unsigned tg = og / nx;
            if (og + 1u == (tg + 1u) * nx) xb_add(&bar[XB_TOPGEN], 1u);
            else XB_SPIN(xb_ld(&bar[XB_TOPGEN]) == tg, bar);
            __builtin_amdgcn_fence(__ATOMIC_ACQUIRE, "agent");
            xb_add(&bar[XB_XGEN(bx)], 1u);
            asm volatile("s_waitcnt vmcnt(0)" ::: "memory");
        } else {
            XB_SPIN(xb_ld(&bar[XB_XGEN(bx)]) == gen, bar);
            __builtin_amdgcn_fence(__ATOMIC_ACQUIRE, "agent");
            asm volatile("s_waitcnt vmcnt(0)" ::: "memory");
        }
    }
    __syncthreads();
}

constexpr int LDS_BYTES = 147456;
constexpr int LDS_MISC = 131072;
struct Args { const float* in[33]; float* out; unsigned char* ws; int ph_lo, ph_hi; };
struct Frame { const float* const* in; float* out; unsigned char* ws; LAS unsigned char* lds; int tid, lane, wave, G, bid, wave0; };
#define IN_XP 0
#define IN_XS 1
#define IN_CK 2
#define IN_CV 3
#define IN_SF 4
#define IN_SB 5
#define IN_C 6
#define IN_CCTX 7
#define IN_WMOD 8
#define IN_BMOD 9
#define IN_GPRE1 10
#define IN_GPOST1 11
#define IN_GPRE2 12
#define IN_GPOST2 13
#define IN_WIN 14
#define IN_WA2F 15
#define IN_BAF 16
#define IN_WA2B 17
#define IN_BAB 18
#define IN_GGLA 19
#define IN_LQ1 20
#define IN_LK1 21
#define IN_LQ2 22
#define IN_LK2 23
#define IN_GDIFF 24
#define IN_WBRG 25
#define IN_WBRF 26
#define IN_WBRD 27
#define IN_WOUT 28
#define IN_WUP 29
#define IN_CONVW 30
#define IN_CONVB 31
#define IN_WDOWN 32
#define WSB(off) ((bf16_t*)(F.ws + (off)))
#define WSF(off) ((float*)(F.ws + (off)))

__device__ __forceinline__ void ph_prologue(const Frame& F) {
    LAS float* red = (LAS float*)F.lds;
    const float* cctx = F.in[IN_CCTX]; const float* cc = F.in[IN_C];
    LAS float* sl = (LAS float*)(F.lds + 32768);
    for (int i = F.tid; i < 3 * 2048; i += 512) sl[i] = silu_f(i < 2048 ? cctx[i] : cc[i - 2048]);
    __syncthreads();
    for (int it = F.bid; it < 384; it += F.G) {
        const int l = it / 192, col0 = (it % 192) * 64, kg = F.tid >> 4, cq = F.tid & 15;
        const float* W = F.in[IN_WMOD] + (size_t)l * 2048 * NMOD + col0 + 4 * cq;
        f32x4 a0 = {0.f, 0.f, 0.f, 0.f}, a1 = a0, a2 = a0;
#pragma unroll 16
        for (int kk = 0; kk < 64; ++kk) { const int k = kg * 64 + kk;
            const float s0 = sl[k], s1 = sl[2048 + k], s2 = sl[4096 + k];
            const f32x4 w = *(const f32x4*)(W + (size_t)k * NMOD);
            a0 += s0 * w; a1 += s1 * w; a2 += s2 * w; }
        *(LAS f32x4*)(red + (kg * 3 + 0) * 64 + 4 * cq) = a0; *(LAS f32x4*)(red + (kg * 3 + 1) * 64 + 4 * cq) = a1; *(LAS f32x4*)(red + (kg * 3 + 2) * 64 + 4 * cq) = a2;
        __syncthreads();
        if (F.tid < 192) { const int r = F.tid >> 6, col = F.tid & 63; float s = 0.f;
            for (int k2 = 0; k2 < 32; ++k2) s += red[(k2 * 3 + r) * 64 + col];
            WSF(WS_MOD)[(size_t)(l * 3 + r) * NMOD + col0 + col] = s + F.in[IN_BMOD][(size_t)l * NMOD + col0 + col]; }
        __syncthreads();
    }
    const size_t n512 = (size_t)1024 * 512 / 8, n256 = (size_t)256 * 512 / 8, n2048 = (size_t)1024 * 4096 / 8;
    const int tb0 = F.G > 128 ? 128 : 0;
    if (F.bid >= tb0)
    for (size_t i = (size_t)(F.bid - tb0) * 512 + F.tid; i < n512 + n256 + n2048; i += (size_t)(F.G - tb0) * 512) {
        float v[8]; bf16_t* dst;
        if (i < n512) { const int m = (int)(i / 64), c0 = (int)(i % 64) * 8, ch = m & 511, cs = m >> 9;
#pragma unroll
            for (int j = 0; j < 8; ++j) { const float rev = (float)((ch * (c0 + j)) & 511) * (1.0f / 512.0f); v[j] = (cs ? __builtin_amdgcn_sinf(rev) : __builtin_amdgcn_cosf(rev)) * 0.04419417382415922f; }
            dst = WSB(WS_T512) + (size_t)m * 512 + c0;
        } else if (i < n512 + n256) { const size_t q = i - n512; const int pos = (int)(q / 64), k0 = (int)(q % 64) * 8;
#pragma unroll
            for (int j = 0; j < 8; ++j) { const int kk = k0 + j, cs = kk >> 8, l = kk & 255; const float rev = (float)((pos * l) & 255) * (1.0f / 256.0f); v[j] = (cs ? -__builtin_amdgcn_sinf(rev) : __builtin_amdgcn_cosf(rev)) * 0.0625f; }
            dst = WSB(WS_T256) + (size_t)pos * 512 + k0;
        } else { const size_t q = i - n512 - n256; const int pos = (int)(q / 512), k0 = (int)(q % 512) * 8;
#pragma unroll
            for (int j = 0; j < 8; ++j) { const int kk = k0 + j, cs = kk >> 11, l = kk & 2047; const float rev = (float)((pos * l) & 2047) * (1.0f / 2048.0f); v[j] = (cs ? -__builtin_amdgcn_sinf(rev) : __builtin_amdgcn_cosf(rev)) * 0.022097086912079608f; }
            dst = WSB(WS_T2048) + (size_t)pos * 4096 + k0;
        }
        *(u32x4*)dst = pack8(v);
    }
}

template <int RMAP = 0>
__device__ __forceinline__ void transpose_item(const float* W, int ldw, int K, int c0, int nblk, bf16_t* WT, int r0, LAS float* scr, int item, int lane) {
    const int kb = item / nblk, nb = item % nblk, k0 = 64 * kb, n0 = 32 * nb;
    const int rd0 = (RMAP == 0) ? r0 + n0 : ((n0 < DFF) ? n0 + 128 * (n0 >> 7) : (n0 - DFF) + 128 * ((n0 - DFF) >> 7) + 128);
    float tv[32]; const float* wp = W + (size_t)(k0 + (lane >> 5)) * ldw + c0 + n0 + (lane & 31);
#pragma unroll
    for (int i = 0; i < 32; ++i) tv[i] = wp[(size_t)(2 * i) * ldw];
#pragma unroll
    for (int i = 0; i < 32; ++i) scr[(2 * i + (lane >> 5)) * 33 + (lane & 31)] = tv[i];
    asm volatile("s_waitcnt lgkmcnt(0)" ::: "memory");
    const int c = lane & 7;
#pragma unroll
    for (int j = 0; j < 4; ++j) { const int n = (lane >> 3) + 8 * j; const LAS float* s = scr + (8 * c) * 33 + n;
        u32x4 o; o.x = pk2(s[0 * 33], s[1 * 33]); o.y = pk2(s[2 * 33], s[3 * 33]); o.z = pk2(s[4 * 33], s[5 * 33]); o.w = pk2(s[6 * 33], s[7 * 33]);
        *(u32x4*)(WT + (size_t)(rd0 + n) * K + k0 + 8 * c) = o; }
    asm volatile("s_waitcnt lgkmcnt(0)" ::: "memory");
}
__device__ __forceinline__ void ph_weights(const Frame& F, int l) {
    LAS float* scr = (LAS float*)(F.lds + F.wave * 8448);
    const int gw = F.bid * 8 + F.wave, NGW = F.G * 8;
    const float* win = F.in[IN_WIN] + (size_t)l * 2048 * NIN_SRC;
    bf16_t* wt = WSB(WS_WIN);
    constexpr int T_IN = 32 * 641, T_BR = 32 * 64, T_UP = 32 * 352, T_DN = 88 * 64;
    constexpr int NIT = T_IN + 3 * T_BR + T_BR + T_UP + T_DN;
    for (int it = gw; it < NIT; it += NGW) {
        int r = it;
#define SEC(Wp, ldw, Kk, c0, nc, dst, r0) { constexpr int n_ = ((Kk) / 64) * ((nc) / 32); if (r < n_) { transpose_item(Wp, ldw, Kk, c0, (nc) / 32, dst, r0, scr, r, F.lane); continue; } r -= n_; }
        SEC(win, NIN_SRC, 2048, 0, 1024, wt, 0)
        SEC(win, NIN_SRC, 2048, 1024, 1024, wt, 1024)
        SEC(win, NIN_SRC, 2048, 4128, 2048, wt, 2048)
        SEC(win, NIN_SRC, 2048, 6176, 2048, wt, 4096)
        SEC(win, NIN_SRC, 2048, 8224, 2048, wt, 6144)
        SEC(win, NIN_SRC, 2048, 10272, 2048, wt, 8192)
        SEC(win, NIN_SRC, 2048, 12320, 2048, wt, 10240)
        SEC(win, NIN_SRC, 2048, 14368, 6144, wt, 12288)
        SEC(win, NIN_SRC, 2048, 4096, 32, wt, 18432)
        SEC(win, NIN_SRC, 2048, 2048, 2048, wt, 18688)
        SEC(F.in[IN_WBRG] + (size_t)l * 2048 * 2048, 2048, 2048, 0, 2048, WSB(WS_WBR), 0)
        SEC(F.in[IN_WBRF] + (size_t)l * 2048 * 2048, 2048, 2048, 0, 2048, WSB(WS_WBR), 2048)
        SEC(F.in[IN_WBRD] + (size_t)l * 2048 * 2048, 2048, 2048, 0, 2048, WSB(WS_WBR), 4096)
        SEC(F.in[IN_WOUT] + (size_t)l * 2048 * 2048, 2048, 2048, 0, 2048, WSB(WS_WOUT), 0)
        { constexpr int n_ = 32 * 352; if (r < n_) { transpose_item<1>(F.in[IN_WUP] + (size_t)l * 2048 * NUP, NUP, 2048, 0, 352, WSB(WS_WUP), 0, scr, r, F.lane); continue; } r -= n_; }
        SEC(F.in[IN_WDOWN] + (size_t)l * DFF * 2048, 2048, DFF, 0, 2048, WSB(WS_WDOWN), 0)
#undef SEC
    }
    { u32x4* z = (u32x4*)(wt + (size_t)18464 * 2048); const size_t n = (size_t)224 * 2048 * 2 / 16;
        unsigned z0 = 0u; asm volatile("" : "+v"(z0));
        for (size_t i = (size_t)F.bid * 512 + F.tid; i < n; i += (size_t)F.G * 512) z[i] = (u32x4){z0, z0, z0, z0}; }
}

__device__ __forceinline__ const float* x_row(const Frame& F, int l, int m) {
    if (l == 0) return m < RC ? F.in[IN_XP] + (size_t)m * D : F.in[IN_XS] + (size_t)(m - RC) * D;
    return F.out + (size_t)m * D;
}
__device__ __forceinline__ const float* mod_row(const Frame& F, int l, int m) { const int cond = m < RC ? 0 : 1 + ((m - RC) >> 11); return WSF(WS_MOD) + (size_t)(l * 3 + cond) * NMOD; }
__device__ __forceinline__ void ph_norm1(const Frame& F, int l) {
    const int gw = F.bid * 8 + F.wave, NGW = F.G * 8;
    const float* g = F.in[IN_GPRE1] + (size_t)l * D;
    for (int m0 = gw; m0 < R; m0 += 2 * NGW) {
        const bool ok1 = m0 + NGW < R; const int mm[2] = {m0, ok1 ? m0 + NGW : m0};
        f32x4 v[2][8];
#pragma unroll
        for (int u = 0; u < 2; ++u) { const f32x4* xr = (const f32x4*)x_row(F, l, mm[u]) + F.lane;
#pragma unroll
            for (int j = 0; j < 8; ++j) v[u][j] = xr[64 * j]; }
#pragma unroll
        for (int u = 0; u < 2; ++u) { float ss = 0.f;
#pragma unroll
            for (int j = 0; j < 8; ++j) ss += (v[u][j].x * v[u][j].x + v[u][j].y * v[u][j].y) + (v[u][j].z * v[u][j].z + v[u][j].w * v[u][j].w);
            const float rinv = rsqrtf(wave_sum(ss, F.lane) * (1.0f / D) + EPS); const float* md = mod_row(F, l, mm[u]);
            u32x2* o = (u32x2*)(WSB(WS_H) + (size_t)mm[u] * D) + F.lane;
            if (u == 0 || ok1) {
#pragma unroll
                for (int j = 0; j < 8; ++j) { const int c = 256 * j + 4 * F.lane; const f32x4 gg = *(const f32x4*)(g + c), sh = *(const f32x4*)(md + c), sc = *(const f32x4*)(md + 2048 + c);
                    const f32x4 y = v[u][j] * rinv * gg * (1.0f + sc) + sh; u32x2 w; w.x = pk2(y.x, y.y); w.y = pk2(y.z, y.w); o[64 * j] = w; } } }
    }
}
__device__ __forceinline__ void ph_cache(const Frame& F, int l) {
    const int gw = F.bid * 8 + F.wave, NGW = F.G * 8;
    for (int i = gw; i < 1024; i += NGW) { const int t = i >> 9, b = (i >> 8) & 1, j = i & 255;
        const f32x4* src = (const f32x4*)((t ? F.in[IN_CV] : F.in[IN_CK]) + ((size_t)(b * 2 + l) * 256 + j) * D) + F.lane;
        u32x2* o = (u32x2*)(WSB(t ? WS_DV : WS_DK) + (size_t)(RC + b * 2304 + j) * D) + F.lane;
#pragma unroll
        for (int jj = 0; jj < 8; ++jj) { const f32x4 y = src[64 * jj]; u32x2 w; w.x = pk2(y.x, y.y); w.y = pk2(y.z, y.w); o[64 * jj] = w; }
    }
}
template <bool XBF>
__device__ __forceinline__ void ph_mid(const Frame& F, int l) {
    const int gw = F.bid * 8 + F.wave, NGW = F.G * 8;
    const float* gp1 = F.in[IN_GPOST1] + (size_t)l * D; const float* g2 = F.in[IN_GPRE2] + (size_t)l * D;
    for (int m0 = gw; m0 < R; m0 += 2 * NGW) {
        const bool ok1 = m0 + NGW < R; const int mm[2] = {m0, ok1 ? m0 + NGW : m0};
        u32x2 yw[2][8], yw2[2][8]; f32x4 xv[2][8]; u32x2 xw[2][8];
#pragma unroll
        for (int u = 0; u < 2; ++u) { const u32x2* yr = (const u32x2*)(WSB(WS_YOUT) + (size_t)mm[u] * D) + F.lane;
            if constexpr (XBF) { const u32x2* xr = (const u32x2*)(WSB(WS_XB2) + (size_t)mm[u] * D) + F.lane;
#pragma unroll
                for (int j = 0; j < 8; ++j) { yw[u][j] = yr[64 * j]; xw[u][j] = xr[64 * j]; }
            } else { const f32x4* xr = (const f32x4*)x_row(F, 0, mm[u]) + F.lane;
#pragma unroll
                for (int j = 0; j < 8; ++j) { yw[u][j] = yr[64 * j]; xv[u][j] = xr[64 * j]; } }
            const bool latr = mm[u] >= RC; const u32x2* yr2 = (const u32x2*)(WSB(WS_KENDT) + (size_t)(latr ? mm[u] - RC : 0) * D) + F.lane;
#pragma unroll
            for (int j = 0; j < 8; ++j) yw2[u][j] = latr ? yr2[64 * j] : (u32x2){0u, 0u}; }
#pragma unroll
        for (int u = 0; u < 2; ++u) { const float* md = mod_row(F, l, mm[u]); f32x4 y[8]; float ss = 0.f;
#pragma unroll
            for (int j = 0; j < 8; ++j) { y[j] = (f32x4){lo16(yw[u][j].x) + lo16(yw2[u][j].x), hi16(yw[u][j].x) + hi16(yw2[u][j].x), lo16(yw[u][j].y) + lo16(yw2[u][j].y), hi16(yw[u][j].y) + hi16(yw2[u][j].y)}; ss += (y[j].x * y[j].x + y[j].y * y[j].y) + (y[j].z * y[j].z + y[j].w * y[j].w); }
            const float rinv = rsqrtf(wave_sum(ss, F.lane) * (1.0f / D) + EPS);
            float s2 = 0.f; u32x2* xo = (u32x2*)(WSB(WS_X1B) + (size_t)mm[u] * D) + F.lane; const bool st = (u == 0 || ok1);
#pragma unroll
            for (int j = 0; j < 8; ++j) { const int c = 256 * j + 4 * F.lane; const f32x4 gg = *(const f32x4*)(gp1 + c), gt = *(const f32x4*)(md + 4096 + c);
                f32x4 xin; if constexpr (XBF) xin = (f32x4){lo16(xw[u][j].x), hi16(xw[u][j].x), lo16(xw[u][j].y), hi16(xw[u][j].y)}; else xin = xv[u][j];
                const f32x4 x1 = xin + gt * (y[j] * rinv * gg); y[j] = x1; if (st) { u32x2 w; w.x = pk2(x1.x, x1.y); w.y = pk2(x1.z, x1.w); xo[64 * j] = w; } s2 += (x1.x * x1.x + x1.y * x1.y) + (x1.z * x1.z + x1.w * x1.w); }
            const float rinv2 = rsqrtf(wave_sum(s2, F.lane) * (1.0f / D) + EPS);
            u32x2* o = (u32x2*)(WSB(WS_H) + (size_t)mm[u] * D) + F.lane;
            if (st) {
#pragma unroll
                for (int j = 0; j < 8; ++j) { const int c = 256 * j + 4 * F.lane; const f32x4 gg = *(const f32x4*)(g2 + c), sh = *(const f32x4*)(md + 6144 + c), sc = *(const f32x4*)(md + 8192 + c);
                    const f32x4 h = y[j] * rinv2 * gg * (1.0f + sc) + sh; u32x2 w; w.x = pk2(h.x, h.y); w.y = pk2(h.z, h.w); o[64 * j] = w; } } }
    }
}
template <bool NEXT>
__device__ __forceinline__ void ph_final(const Frame& F, int l) {
    const int gw = F.bid * 8 + F.wave, NGW = F.G * 8;
    const float* gp2 = F.in[IN_GPOST2] + (size_t)l * D; const float* g1n = F.in[IN_GPRE1] + (size_t)(l + 1) * D;
    for (int m0 = gw; m0 < R; m0 += 2 * NGW) {
        const bool ok1 = m0 + NGW < R; const int mm[2] = {m0, ok1 ? m0 + NGW : m0};
        u32x2 ya[2][8], yb[2][8], xw[2][8];
#pragma unroll
        for (int u = 0; u < 2; ++u) { const u32x2* yr = (const u32x2*)(WSB(WS_YOUT) + (size_t)mm[u] * D) + F.lane; const u32x2* yr1 = (const u32x2*)(WSB(WS_OINTRA) + (size_t)mm[u] * D) + F.lane; const u32x2* xr = (const u32x2*)(WSB(WS_X1B) + (size_t)mm[u] * D) + F.lane;
#pragma unroll
            for (int j = 0; j < 8; ++j) { ya[u][j] = yr[64 * j]; yb[u][j] = (mm[u] >= RC) ? yr1[64 * j] : (u32x2){0u, 0u}; xw[u][j] = xr[64 * j]; } }
#pragma unroll
        for (int u = 0; u < 2; ++u) { const float* md = mod_row(F, l, mm[u]); f32x4 y[8]; float ss = 0.f;
#pragma unroll
            for (int j = 0; j < 8; ++j) { y[j] = (f32x4){lo16(ya[u][j].x) + lo16(yb[u][j].x), hi16(ya[u][j].x) + hi16(yb[u][j].x), lo16(ya[u][j].y) + lo16(yb[u][j].y), hi16(ya[u][j].y) + hi16(yb[u][j].y)}; ss += (y[j].x * y[j].x + y[j].y * y[j].y) + (y[j].z * y[j].z + y[j].w * y[j].w); }
            const float rinv = rsqrtf(wave_sum(ss, F.lane) * (1.0f / D) + EPS);
            f32x4* xo = (f32x4*)(F.out + (size_t)mm[u] * D) + F.lane; u32x2* xo2 = (u32x2*)(WSB(WS_XB2) + (size_t)mm[u] * D) + F.lane; float s2 = 0.f; const bool st = (u == 0 || ok1);
#pragma unroll
            for (int j = 0; j < 8; ++j) { const int c = 256 * j + 4 * F.lane; const f32x4 gg = *(const f32x4*)(gp2 + c), gt = *(const f32x4*)(md + 10240 + c);
                const f32x4 xin = (f32x4){lo16(xw[u][j].x), hi16(xw[u][j].x), lo16(xw[u][j].y), hi16(xw[u][j].y)};
                const f32x4 x2 = xin + gt * (y[j] * rinv * gg);
                if (st) { if constexpr (NEXT) { u32x2 w; w.x = pk2(x2.x, x2.y); w.y = pk2(x2.z, x2.w); xo2[64 * j] = w; } else xo[64 * j] = x2; }
                y[j] = x2; s2 += (x2.x * x2.x + x2.y * x2.y) + (x2.z * x2.z + x2.w * x2.w); }
            if constexpr (NEXT) {
                const float rinv2 = rsqrtf(wave_sum(s2, F.lane) * (1.0f / D) + EPS); const float* mdn = mod_row(F, l + 1, mm[u]);
                u32x2* o = (u32x2*)(WSB(WS_H) + (size_t)mm[u] * D) + F.lane;
                if (st) {
#pragma unroll
                    for (int j = 0; j < 8; ++j) { const int c = 256 * j + 4 * F.lane; const f32x4 gg = *(const f32x4*)(g1n + c), sh = *(const f32x4*)(mdn + c), sc = *(const f32x4*)(mdn + 2048 + c);
                        const f32x4 h = y[j] * rinv2 * gg * (1.0f + sc) + sh; u32x2 w; w.x = pk2(h.x, h.y); w.y = pk2(h.z, h.w); o[64 * j] = w; } }
            } }
    }
}
__device__ __forceinline__ float diff_lambda(const Frame& F, int l, float& lam_init) {
    const float* q1 = F.in[IN_LQ1] + l * 128; const float* k1 = F.in[IN_LK1] + l * 128; const float* q2 = F.in[IN_LQ2] + l * 128; const float* k2 = F.in[IN_LK2] + l * 128;
    const float s1 = wave_sum(q1[F.lane] * k1[F.lane] + q1[64 + F.lane] * k1[64 + F.lane], F.lane);
    const float s2 = wave_sum(q2[F.lane] * k2[F.lane] + q2[64 + F.lane] * k2[64 + F.lane], F.lane);
    lam_init = 0.8f - 0.6f * __expf(-0.3f * (float)l);
    return __expf(s1) - __expf(s2) + lam_init;
}
__device__ __forceinline__ void ph_postmix(const Frame& F, int l) {
    const int gw = F.bid * 8 + F.wave, NGW = F.G * 8;
    float lam_init; const float lam = diff_lambda(F, l, lam_init);
    const float* ggla = F.in[IN_GGLA] + (size_t)l * 512 + 8 * F.lane; const float* gdiff = F.in[IN_GDIFF] + (size_t)l * 256 + 8 * (F.lane & 31);
    float gg[8], gd[8];
#pragma unroll
    for (int j = 0; j < 8; ++j) { gg[j] = ggla[j]; gd[j] = gdiff[j]; }
    for (int i = gw; i < 4096; i += NGW) { const int b = i >> 11, r = i & 2047;
        const bf16_t* yc = WSB(WS_Y) + (size_t)r * 24576 + 16384 + (size_t)b * 4096; float a = 0.f;
#pragma unroll
        for (int q = 0; q < 4; ++q) { float f[8]; unpack8(*(const u32x4*)(yc + (q * 64 + F.lane) * 8), f); a += ((f[0] - f[1]) + (f[2] - f[3])) + ((f[4] - f[5]) + (f[6] - f[7])); }
        a = wave_sum(a, F.lane) * 0.022097086912079608f;
        if (F.lane == 0) WSB(WS_OFNET)[(size_t)(RC + b * 2048 + 1024) * D + r] = (bf16_t)f2bf(a); }
    for (int i = F.bid * 512 + F.tid; i < 2 * 1023 * 256; i += F.G * 512) { const int c8 = i & 255, rest = i >> 8, b = rest / 1023, pos = 1025 + (rest - b * 1023), g = c8 >> 6, c0 = (c8 & 63) * 8;
        const bf16_t* srow = WSB(WS_OFNET) + (size_t)(RC + b * 2048 + (2048 - pos)) * D + g * 512;
        unsigned e[8];
#pragma unroll
        for (int j = 0; j < 8; ++j) e[j] = srow[(512 - (c0 + j)) & 511];
        u32x4 w; w.x = e[0] | (e[1] << 16); w.y = e[2] | (e[3] << 16); w.z = e[4] | (e[5] << 16); w.w = e[6] | (e[7] << 16);
        *(u32x4*)(WSB(WS_OFNET) + (size_t)(RC + b * 2048 + pos) * D + g * 512 + c0) = w; }
    for (int m = gw; m < R; m += NGW) {
        const size_t ro = (size_t)m * D + 8 * F.lane; const size_t po = (size_t)m * 4096 + (F.lane >> 5) * 512 + (F.lane & 31) * 8;
        u32x4 wa[4], wb[4], wc[4], wz[4], p1[4], p2[4];
#pragma unroll
        for (int q = 0; q < 4; ++q) { wa[q] = *(const u32x4*)(WSB(WS_OINTRA) + ro + 512 * q); wb[q] = *(const u32x4*)(WSB(WS_OF) + ro + 512 * q); wc[q] = *(const u32x4*)(WSB(WS_OB) + ro + 512 * q);
            wz[q] = *(const u32x4*)(WSB(WS_ZG) + ro + 512 * q); p1[q] = *(const u32x4*)(WSB(WS_OPART) + po + 1024 * q); p2[q] = *(const u32x4*)(WSB(WS_OPART) + po + 1024 * q + 256); }
#pragma unroll
        for (int q = 0; q < 4; ++q) {
            float a[8], b[8], c[8], zg[8], r[8]; unpack8(wa[q], a); unpack8(wb[q], b); unpack8(wc[q], c); unpack8(wz[q], zg); float ss = 0.f;
#pragma unroll
            for (int j = 0; j < 8; ++j) { a[j] += b[j] + c[j]; ss += a[j] * a[j]; }
            const float rinv = rsqrtf(wave_sum(ss, F.lane) * (1.0f / 512.0f) + EPS);
#pragma unroll
            for (int j = 0; j < 8; ++j) r[j] = a[j] * rinv * gg[j] * silu_f(zg[j]);
            *(u32x4*)(WSB(WS_AGLA) + ro + 512 * q) = pack8(r); }
#pragma unroll
        for (int q = 0; q < 4; ++q) {
            float a[8], b[8], r[8]; unpack8(p1[q], a); unpack8(p2[q], b); float ss = 0.f;
#pragma unroll
            for (int j = 0; j < 8; ++j) { a[j] -= lam * b[j]; ss += a[j] * a[j]; }
            ss += shx(ss, 1, F.lane); ss += shx(ss, 2, F.lane); ss += shx(ss, 4, F.lane); ss += shx(ss, 8, F.lane); ss += shx(ss, 16, F.lane);
            const float rinv = rsqrtf(ss * (1.0f / 256.0f) + EPS) * (1.0f - lam_init);
#pragma unroll
            for (int j = 0; j < 8; ++j) r[j] = a[j] * rinv * gd[j];
            *(u32x4*)(WSB(WS_ADIFF) + ro + 512 * q) = pack8(r); }
    }
}
__device__ __forceinline__ void ph_merge(const Frame& F) {
    const size_t n = (size_t)R * D / 8, st = (size_t)F.G * 512;
    const u32x4* p0 = (const u32x4*)(F.ws + WS_DQ); const u32x4* p1 = (const u32x4*)(F.ws + WS_DK); const u32x4* p2 = (const u32x4*)(F.ws + WS_DV); const u32x4* p3 = (const u32x4*)(F.ws + WS_QIN); u32x4* o = (u32x4*)(F.ws + WS_MERGED);
    for (size_t i = (size_t)F.bid * 512 + F.tid; i < n; i += 2 * st) { const size_t i2 = i + st; const bool has2 = i2 < n; const size_t j2 = has2 ? i2 : i;
        constexpr size_t lat0 = (size_t)RC * D / 8; const u32x4 zz = {0u, 0u, 0u, 0u};
        const u32x4 a0 = p0[i], b0 = p1[i], c0 = p2[i], a1 = p0[j2], b1 = p1[j2], c1 = p2[j2];
        const u32x4 d0 = i >= lat0 ? p3[i - lat0] : zz, d1 = j2 >= lat0 ? p3[j2 - lat0] : zz;
        float a[8], b[8], c[8], d[8]; unpack8(a0, a); unpack8(b0, b); unpack8(c0, c); unpack8(d0, d);
#pragma unroll
        for (int j = 0; j < 8; ++j) a[j] += (b[j] + c[j]) + d[j];
        o[i] = pack8(a);
        unpack8(a1, a); unpack8(b1, b); unpack8(c1, c); unpack8(d1, d);
#pragma unroll
        for (int j = 0; j < 8; ++j) a[j] += (b[j] + c[j]) + d[j];
        if (has2) o[i2] = pack8(a); }
}
__device__ __forceinline__ void ph_conv(const Frame& F, int l) {
    constexpr int NS = DFF / 8; const size_t n = (size_t)NS * (R / 32);
    const float* cw = F.in[IN_CONVW] + (size_t)l * 3 * DFF; const float* cb = F.in[IN_CONVB] + (size_t)l * DFF;
    const bf16_t* sg = WSB(WS_SG); const bf16_t* sv = WSB(WS_SV); bf16_t* A = WSB(WS_ACT);
    for (size_t i = (size_t)F.bid * 512 + F.tid; i < n; i += (size_t)F.G * 512) {
        const int j0 = (int)(i % NS) * 8, br = (int)(i / NS), q = br >> 1, last = br & 1, r = q * 64 + (last ? 63 : 0);
        if (r < 256 || (r < 512 && j0 < 2560)) continue;
        const int s = r < RC ? (r & 255) : ((r - RC) & 2047), Ls = r < RC ? 256 : 2048;
        const u32x4 zz = {0u, 0u, 0u, 0u};
        u32x4 gp, gc, gn, vv;
        if (!last) { gc = *(const u32x4*)(sg + (size_t)(q * 4 + 0) * DFF + j0); gn = *(const u32x4*)(sg + (size_t)(q * 4 + 1) * DFF + j0); gp = (s > 0) ? *(const u32x4*)(sg + (size_t)(q * 4 - 1) * DFF + j0) : zz; vv = *(const u32x4*)(sv + (size_t)(q * 2) * DFF + j0); }
        else { gc = *(const u32x4*)(sg + (size_t)(q * 4 + 3) * DFF + j0); gp = *(const u32x4*)(sg + (size_t)(q * 4 + 2) * DFF + j0); gn = (s < Ls - 1) ? *(const u32x4*)(sg + (size_t)(q * 4 + 4) * DFF + j0) : zz; vv = *(const u32x4*)(sv + (size_t)(q * 2 + 1) * DFF + j0); }
        float g0[8], g1[8], g2[8], val[8], rr[8]; unpack8(gp, g0); unpack8(gc, g1); unpack8(gn, g2); unpack8(vv, val);
#pragma unroll
        for (int j = 0; j < 8; ++j) { const float gt = g0[j] * cw[j0 + j] + g1[j] * cw[DFF + j0 + j] + g2[j] * cw[2 * DFF + j0 + j] + cb[j0 + j]; rr[j] = gelu_tanh_f(gt) * val[j]; }
        *(u32x4*)(A + (size_t)r * DFF + j0) = pack8(rr);
    }
    const bf16_t* P = WSB(WS_UPQ);
    for (int i = F.bid * 512 + F.tid; i < 64 * 256 * 16; i += F.G * 512) {
        const int t = i >> 12, r = (i >> 4) & 255, c0 = (i & 15) * 8, pm = t < 44 ? 0 : 1, pn = t < 44 ? t : t - 44, ch = pn * 128 + c0;
        float val[8], g0[8], g1[8], g2[8], rr[8];
#pragma unroll
        for (int j = 0; j < 8; ++j) { val[j] = 0.f; g0[j] = 0.f; g1[j] = 0.f; g2[j] = 0.f; }
        const u32x4 zz = {0u, 0u, 0u, 0u};
        u32x4 lv[4], lp[4], lc[4], ln[4];
#pragma unroll
        for (int kq = 0; kq < 4; ++kq) { const bf16_t* pr = P + ((size_t)(kq * 64 + t) * 256 + r) * 256 + c0;
            lv[kq] = *(const u32x4*)pr; lc[kq] = *(const u32x4*)(pr + 128); lp[kq] = (r > 0) ? *(const u32x4*)(pr + 128 - 256) : zz; ln[kq] = (r < 255) ? *(const u32x4*)(pr + 128 + 256) : zz; }
#pragma unroll
        for (int kq = 0; kq < 4; ++kq) { float a[8]; unpack8(lv[kq], a);
#pragma unroll
            for (int j = 0; j < 8; ++j) val[j] += a[j];
            unpack8(lp[kq], a);
#pragma unroll
            for (int j = 0; j < 8; ++j) g0[j] += a[j];
            unpack8(lc[kq], a);
#pragma unroll
            for (int j = 0; j < 8; ++j) g1[j] += a[j];
            unpack8(ln[kq], a);
#pragma unroll
            for (int j = 0; j < 8; ++j) g2[j] += a[j]; }
#pragma unroll
        for (int j = 0; j < 8; ++j) { const float gt = g0[j] * cw[ch + j] + g1[j] * cw[DFF + ch + j] + g2[j] * cw[2 * DFF + ch + j] + cb[ch + j]; rr[j] = gelu_tanh_f(gt) * val[j]; }
        *(u32x4*)(A + (size_t)(pm * 256 + r) * DFF + ch) = pack8(rr);
    }
}
__device__ __forceinline__ void ph_rope(const Frame& F) {
    const size_t n = (size_t)RL * 256;
    for (size_t i = (size_t)F.bid * 512 + F.tid; i < n; i += (size_t)F.G * 512) {
        const int rl = (int)(i >> 8), w = (int)(i & 255), isk = w >> 7, blk = (w >> 3) & 15, ax = (w >> 2) & 1, f0 = (w & 3) * 8;
        const int b = rl >> 11, s = rl & 2047; const float pos = (float)(ax ? (s & 63) : (s >> 6));
        bf16_t* p = (isk ? WSB(WS_DK) + (size_t)(RC + b * 2304 + 256 + s) * D : WSB(WS_DQ) + (size_t)(RC + rl) * D) + blk * 128 + ax * 64 + f0;
        float x1[8], x2[8], o1[8], o2[8]; unpack8(*(const u32x4*)p, x1); unpack8(*(const u32x4*)(p + 32), x2);
#pragma unroll
        for (int j = 0; j < 8; ++j) { const float inv = exp2f(-(float)(f0 + j) * (13.287712379549449f / 32.0f)); const float rev = pos * inv * 0.15915494309189535f;
            const float cs = __builtin_amdgcn_cosf(rev), sn = __builtin_amdgcn_sinf(rev); o1[j] = x1[j] * cs - x2[j] * sn; o2[j] = x2[j] * cs + x1[j] * sn; }
        *(u32x4*)p = pack8(o1); *(u32x4*)(p + 32) = pack8(o2);
    }
}

constexpr int GP_QIN = 0, GP_KIN = 33792, GP_AL = 67584, GP_X = 33792, GP_ZA = 100352, GP_TOT = 108800;
constexpr int GP_XS = 260, GP_ZS = 33;
template <int DIR>
__device__ __forceinline__ void gla_pre_dir(const Frame& F, int l, int item, int tok0, int h, f32x4 (&Aacc)[2], const u32x4 (&tq)[4], const u32x4 (&tk)[4], const float (&aw)[2][4], const float bias) {
    LAS bf16_t* qin = (LAS bf16_t*)(F.lds + GP_QIN); LAS bf16_t* kin = (LAS bf16_t*)(F.lds + GP_KIN); LAS float* tot = (LAS float*)(F.lds + GP_TOT); const LAS float* zal = (const LAS float*)(F.lds + GP_ZA);
    const int d = F.tid & 255, half = F.tid >> 8;
#pragma unroll
    for (int i = 0; i < 4; ++i) { const int p = F.tid + 512 * i, row = p >> 5, c16 = p & 31; *(LAS u32x4*)(qin + row * 264 + c16 * 8) = tq[i]; }
    {   LAS float* X = (LAS float*)(F.lds + GP_X);
        const int fr = F.lane & 15, fq = F.lane >> 4;
#pragma unroll
        for (int tt = 0; tt < 4; ++tt) { float bz[4];
#pragma unroll
            for (int s4 = 0; s4 < 4; ++s4) bz[s4] = zal[(16 * tt + fr) * GP_ZS + DIR * 16 + 4 * s4 + fq];
#pragma unroll
            for (int ct = 0; ct < 2; ++ct) { f32x4 acc = {0.f, 0.f, 0.f, 0.f};
#pragma unroll
                for (int s4 = 0; s4 < 4; ++s4) acc = __builtin_amdgcn_mfma_f32_16x16x4f32(aw[ct][s4], bz[s4], acc, 0, 0, 0);
                *(LAS f32x4*)(X + (16 * tt + fr) * GP_XS + 32 * F.wave + 16 * ct + 4 * fq) = acc; } } }
    __syncthreads();
    float cum[32]; float run = 0.f;
    {   const LAS float* xb = (const LAS float*)(F.lds + GP_X) + (32 * half) * GP_XS + d;
#pragma unroll
        for (int jj = 0; jj < 32; ++jj) { const float x = xb[(DIR ? 31 - jj : jj) * GP_XS] + bias; run += logsig_f(x) * 0.0625f; cum[jj] = run; } }
    tot[half * 256 + d] = run;
    __syncthreads();
#pragma unroll
    for (int i = 0; i < 4; ++i) { const int p = F.tid + 512 * i, row = p >> 5, c16 = p & 31; *(LAS u32x4*)(kin + row * 264 + c16 * 8) = tk[i]; }
    const int first = DIR ? 1 : 0; const float off = (half == first) ? 0.f : tot[first * 256 + d]; const float blast = tot[d] + tot[256 + d];
    const float ebl = __expf(blast);
    if (half == 0) WSF(WS_DECAY)[(size_t)(item * 2 + DIR) * 256 + d] = ebl;
    __syncthreads();
    LAS bf16_t* qb = qin + (32 * half) * 264 + d; LAS bf16_t* kb = kin + (32 * half) * 264 + d;
    bf16_t* ke_g = WSB(WS_KENDT) + ((size_t)(item * 2 + DIR) * 256 + d) * 64 + 32 * half;
#pragma unroll
    for (int g8 = 0; g8 < 4; ++g8) { float ke[8];
#pragma unroll
        for (int j8 = 0; j8 < 8; ++j8) { const int jj = 8 * g8 + j8; const int tl = (DIR ? 31 - jj : jj); const float b = cum[jj] + off;
            const float q = bf2f(qb[tl * 264]) * 0.0625f, k = bf2f(kb[tl * 264]);
            const float eb = __expf(b), ieb = __builtin_amdgcn_rcpf(eb); const float qi = q * eb, ki = k * ieb; ke[j8] = ki * ebl;
            qb[tl * 264] = (bf16_t)f2bf(qi); kb[tl * 264] = (bf16_t)f2bf(ki); if ((j8 & 1) == 1) asm volatile("" ::: "memory"); }
        u32x4 pk; int t0;
        if (DIR == 0) { pk.x = pk2(ke[0], ke[1]); pk.y = pk2(ke[2], ke[3]); pk.z = pk2(ke[4], ke[5]); pk.w = pk2(ke[6], ke[7]); t0 = 8 * g8; }
        else { pk.x = pk2(ke[7], ke[6]); pk.y = pk2(ke[5], ke[4]); pk.z = pk2(ke[3], ke[2]); pk.w = pk2(ke[1], ke[0]); t0 = 24 - 8 * g8; }
        *(u32x4*)(ke_g + t0) = pk; asm volatile("" ::: "memory"); }
    __syncthreads();
    {   bf16_t* qg = WSB(WS_QIN) + (size_t)DIR * R * 1024 + (size_t)tok0 * 1024 + h * 256;
#pragma unroll
        for (int i = 0; i < 4; ++i) { const int p = F.tid + 512 * i, row = p >> 5, c16 = p & 31;
            *(u32x4*)(qg + (size_t)row * 1024 + c16 * 8) = *(const LAS u32x4*)(qin + row * 264 + c16 * 8); } }
    const int tm = F.wave >> 1, lr = F.lane & 15, lq = F.lane >> 4;
#pragma unroll
    for (int t2 = 0; t2 < 2; ++t2) { const int tn = 2 * (F.wave & 1) + t2; f32x4 acc = {0.f, 0.f, 0.f, 0.f};
#pragma unroll
        for (int ks = 0; ks < 8; ++ks) { const bf16x8 a = *(const LAS bf16x8*)(qin + (16 * tm + lr) * 264 + 32 * ks + 8 * lq); const bf16x8 b = *(const LAS bf16x8*)(kin + (16 * tn + lr) * 264 + 32 * ks + 8 * lq);
            acc = __builtin_amdgcn_mfma_f32_16x16x32_bf16(a, b, acc, 0, 0, 0); }
#pragma unroll
        for (int i = 0; i < 4; ++i) { const int t = 16 * tm + 4 * lq + i, s = 16 * tn + lr; const bool keep = DIR ? (s >= t) : (s <= t); Aacc[t2][i] += keep ? acc[i] : 0.f; } }
    __syncthreads();
}
__device__ __forceinline__ void gla_pre_item(const Frame& F0, int l, int item) {
    Frame F = F0; F.tid = ltid(F.wave0); F.lane = F.tid & 63; F.wave = F.wave0;
    const int ch = item >> 2, h = item & 3, tok0 = ch * 64;
    LAS float* zal = (LAS float*)(F.lds + GP_ZA); LAS bf16_t* Al = (LAS bf16_t*)(F.lds + GP_AL);
    const int tm = F.wave >> 1, lr = F.lane & 15, lq = F.lane >> 4;
    f32x4 z4;
    {   const f32x4* zp_ = (const f32x4*)(WSF(WS_ZAP) + (size_t)tok0 * 32) + F.tid; constexpr size_t qs = (size_t)R * 32 / 4;
        const f32x4 z0 = zp_[0], z1 = zp_[qs], z2 = zp_[2 * qs], z3 = zp_[3 * qs]; z4 = (z0 + z1) + (z2 + z3); }
    u32x4 tq[4], tk[4];
    {   const bf16_t* zq = WSB(WS_ZQ) + (size_t)tok0 * 1024 + h * 256; const bf16_t* zk = WSB(WS_ZK) + (size_t)tok0 * 1024 + h * 256;
#pragma unroll
        for (int i = 0; i < 4; ++i) { const int p = F.tid + 512 * i, row = p >> 5, c16 = p & 31; tq[i] = *(const u32x4*)(zq + (size_t)row * 1024 + c16 * 8); tk[i] = *(const u32x4*)(zk + (size_t)row * 1024 + c16 * 8); } }
    bf16x8 va0[4], va1[4];
    {   const bf16_t* vt = WSB(WS_ZVT);
#pragma unroll
        for (int v4 = 0; v4 < 4; ++v4) { const bf16_t* vp = vt + (size_t)(h * 512 + 16 * (4 * F.wave + v4) + lr) * R + tok0 + 8 * lq; va0[v4] = *(const bf16x8*)vp; va1[v4] = *(const bf16x8*)(vp + 32); } }
    float awf[2][4], awb[2][4];
    {   const float* wf = F.in[IN_WA2F] + (size_t)l * 16 * 1024 + h * 256 + 32 * F.wave + lr; const float* wb = F.in[IN_WA2B] + (size_t)l * 16 * 1024 + h * 256 + 32 * F.wave + lr;
#pragma unroll
        for (int ct = 0; ct < 2; ++ct)
#pragma unroll
            for (int s4 = 0; s4 < 4; ++s4) { awf[ct][s4] = wf[(size_t)(4 * s4 + lq) * 1024 + 16 * ct]; awb[ct][s4] = wb[(size_t)(4 * s4 + lq) * 1024 + 16 * ct]; } }
    const float biasf = F.in[IN_BAF][(size_t)l * 1024 + h * 256 + (F.tid & 255)], biasb = F.in[IN_BAB][(size_t)l * 1024 + h * 256 + (F.tid & 255)];
    { LAS float* zp = zal + (F.tid >> 3) * GP_ZS + (F.tid & 7) * 4; zp[0] = z4.x; zp[1] = z4.y; zp[2] = z4.z; zp[3] = z4.w; }
    __syncthreads();
    f32x4 Aacc[2] = {{0.f, 0.f, 0.f, 0.f}, {0.f, 0.f, 0.f, 0.f}};
    gla_pre_dir<0>(F, l, item, tok0, h, Aacc, tq, tk, awf, biasf);
    gla_pre_dir<1>(F, l, item, tok0, h, Aacc, tq, tk, awb, biasb);
#pragma unroll
    for (int t2 = 0; t2 < 2; ++t2) { const int tn = 2 * (F.wave & 1) + t2;
#pragma unroll
        for (int i = 0; i < 4; ++i) Al[(16 * tm + 4 * lq + i) * 72 + 16 * tn + lr] = (bf16_t)f2bf(Aacc[t2][i]); }
    __syncthreads();
    bf16_t* oi = WSB(WS_OINTRA);
#pragma unroll
    for (int v4 = 0; v4 < 4; ++v4) { const int vtile = 4 * F.wave + v4;
        const bf16x8 a0 = va0[v4], a1 = va1[v4];
#pragma unroll
        for (int tt = 0; tt < 4; ++tt) { const bf16x8 b0 = *(const LAS bf16x8*)(Al + (16 * tt + lr) * 72 + 8 * lq), b1 = *(const LAS bf16x8*)(Al + (16 * tt + lr) * 72 + 32 + 8 * lq);
            f32x4 acc = {0.f, 0.f, 0.f, 0.f}; acc = __builtin_amdgcn_mfma_f32_16x16x32_bf16(a0, b0, acc, 0, 0, 0); acc = __builtin_amdgcn_mfma_f32_16x16x32_bf16(a1, b1, acc, 0, 0, 0);
            u32x2 w; w.x = pk2(acc[0], acc[1]); w.y = pk2(acc[2], acc[3]);
            *(u32x2*)(oi + (size_t)(tok0 + 16 * tt + lr) * D + h * 512 + 16 * vtile + 4 * lq) = w; } }
    __syncthreads();
}
constexpr int GS_Q = 0, GS_K = 65536, GS_D = 102400;
__device__ __forceinline__ void gla_scan_item(const Frame& F0, int l, int id) {
    Frame F = F0; F.tid = ltid(F.wave0); F.lane = F.tid & 63; F.wave = F.wave0;
    const bool lat = id < 32; const int j = lat ? id : id - 32;
    const int vs = j & 1, dir = (j >> 1) & 1, h = (j >> 2) & 3, b = j >> 4;
    const int cbase = lat ? 128 + 32 * b : 4 * b, nch = lat ? 32 : 4;
    LAS unsigned char* qsb = F.lds + GS_Q; LAS bf16_t* ksm = (LAS bf16_t*)(F.lds + GS_K); LAS float* dl = (LAS float*)(F.lds + GS_D);
    const int lr0 = F.lane & 15, lq0 = F.lane >> 4; const int vcol0 = h * 512 + vs * 256 + 32 * F.wave;
    f32x4 S[16][2];
    const size_t soff = ((size_t)((b * 2 + l) * 4 + h) * 256) * 512 + vs * 256 + 32 * F.wave + lr0;
    if (lat) { const float* st = F.in[dir ? IN_SB : IN_SF] + soff;
#pragma unroll
        for (int mt = 0; mt < 16; ++mt)
#pragma unroll
            for (int i = 0; i < 4; ++i) { S[mt][0][i] = st[(size_t)(16 * mt + 4 * lq0 + i) * 512]; S[mt][1][i] = st[(size_t)(16 * mt + 4 * lq0 + i) * 512 + 16]; if (i == 3) asm volatile("" ::: "memory"); }
    } else {
#pragma unroll
        for (int mt = 0; mt < 16; ++mt) { S[mt][0] = (f32x4){0.f, 0.f, 0.f, 0.f}; S[mt][1] = (f32x4){0.f, 0.f, 0.f, 0.f}; } }
    const bf16_t* qing = WSB(WS_QIN) + (size_t)dir * R * 1024 + h * 256; bf16_t* og = dir ? WSB(WS_OB) : WSB(WS_OF);
    u32x4 pk[4]; f32x4 pd; bf16x8 pv00, pv01, pv10, pv11;
#define GS_DMA_Q(ci_, T_) do { const int qrow0 = 2 * F.wave + (((T_) & 63) >> 5), qcp = (T_) & 31; const int gch_ = cbase + (dir ? nch - 1 - (ci_) : (ci_)); const bf16_t* qb_ = qing + (size_t)gch_ * 64 * 1024; \
        _Pragma("unroll") for (int i = 0; i < 4; ++i) { const int row_ = qrow0 + 16 * i, c_ = (qcp & 16) | ((qcp ^ row_) & 15); \
            __builtin_amdgcn_global_load_lds((const unsigned*)(qb_ + (size_t)row_ * 1024 + c_ * 8), (LAS unsigned*)(qsb + ((ci_) & 1) * 32768 + (8 * i + F.wave) * 1024), 16, 0, 0); } } while (0)
#define GS_LOAD_K(ci_, T_) do { const int lr_ = (T_) & 15, lq_ = ((T_) >> 4) & 3; const int gch_ = cbase + (dir ? nch - 1 - (ci_) : (ci_)), tok0_ = gch_ * 64, item_ = gch_ * 4 + h; \
        const bf16_t* keg_ = WSB(WS_KENDT) + (size_t)(item_ * 2 + dir) * 256 * 64; \
        _Pragma("unroll") for (int i = 0; i < 4; ++i) { const int p = (T_) + 512 * i; pk[i] = *(const u32x4*)(keg_ + (size_t)(p >> 3) * 64 + (p & 7) * 8); } \
        pd = *(const f32x4*)(WSF(WS_DECAY) + (size_t)(item_ * 2 + dir) * 256 + 4 * ((T_) & 63)); \
        const bf16_t* vp_ = WSB(WS_ZVT) + (size_t)(vcol0 + lr_) * R + tok0_ + 8 * lq_; pv00 = *(const bf16x8*)vp_; pv01 = *(const bf16x8*)(vp_ + 32); \
        pv10 = *(const bf16x8*)(vp_ + (size_t)16 * R); pv11 = *(const bf16x8*)(vp_ + (size_t)16 * R + 32); } while (0)
    GS_DMA_Q(0, F.tid); GS_LOAD_K(0, F.tid);
    for (int ci = 0; ci < nch; ++ci) {
        const int gch = cbase + (dir ? nch - 1 - ci : ci), tok0 = gch * 64;
        int tidc = F.tid; asm volatile("" : "+v"(tidc));
        const int lr = tidc & 15, lq = (tidc >> 4) & 3;
        asm volatile("s_waitcnt vmcnt(0)" ::: "memory");
#pragma unroll
        for (int i = 0; i < 4; ++i) { const int p = tidc + 512 * i; *(LAS u32x4*)(ksm + (p >> 3) * 72 + (p & 7) * 8) = pk[i]; }
        if (tidc < 64) *(LAS f32x4*)(dl + 4 * tidc) = pd;
        const bf16x8 vt00 = pv00, vt01 = pv01, vt10 = pv10, vt11 = pv11;
        __syncthreads();
        if (ci + 1 < nch) { GS_DMA_Q(ci + 1, tidc); GS_LOAD_K(ci + 1, tidc); }
        const LAS unsigned char* qs = qsb + (ci & 1) * 32768;
        f32x4 O[4][2];
#pragma unroll
        for (int tt = 0; tt < 4; ++tt) { O[tt][0] = (f32x4){0.f, 0.f, 0.f, 0.f}; O[tt][1] = (f32x4){0.f, 0.f, 0.f, 0.f}; }
#pragma unroll
        for (int ks = 0; ks < 8; ++ks) {
            u32x4 aw0, aw1;
            aw0.x = pk2(S[2 * ks][0][0], S[2 * ks][0][1]); aw0.y = pk2(S[2 * ks][0][2], S[2 * ks][0][3]); aw0.z = pk2(S[2 * ks + 1][0][0], S[2 * ks + 1][0][1]); aw0.w = pk2(S[2 * ks + 1][0][2], S[2 * ks + 1][0][3]);
            aw1.x = pk2(S[2 * ks][1][0], S[2 * ks][1][1]); aw1.y = pk2(S[2 * ks][1][2], S[2 * ks][1][3]); aw1.z = pk2(S[2 * ks + 1][1][0], S[2 * ks + 1][1][1]); aw1.w = pk2(S[2 * ks + 1][1][2], S[2 * ks + 1][1][3]);
            const bf16x8 af0 = __builtin_bit_cast(bf16x8, aw0), af1 = __builtin_bit_cast(bf16x8, aw1);
            const int c0 = 4 * ks + (lq >> 1), c1 = c0 + 2;
            const int o0 = ((c0 & 16) | ((c0 ^ lr) & 15)) * 16 + (lq & 1) * 8, o1 = ((c1 & 16) | ((c1 ^ lr) & 15)) * 16 + (lq & 1) * 8;
#pragma unroll
            for (int tt = 0; tt < 4; ++tt) { const LAS unsigned char* qp = qs + (16 * tt + lr) * 512;
                const u32x2 lo = *(const LAS u32x2*)(qp + o0), hi = *(const LAS u32x2*)(qp + o1); u32x4 bw; bw.x = lo.x; bw.y = lo.y; bw.z = hi.x; bw.w = hi.y; const bf16x8 bf = __builtin_bit_cast(bf16x8, bw);
                O[tt][0] = __builtin_amdgcn_mfma_f32_16x16x32_bf16(af0, bf, O[tt][0], 0, 0, 0); O[tt][1] = __builtin_amdgcn_mfma_f32_16x16x32_bf16(af1, bf, O[tt][1], 0, 0, 0); }
            asm volatile("" ::: "memory"); }
#pragma unroll
        for (int tt = 0; tt < 4; ++tt)
#pragma unroll
            for (int nt2 = 0; nt2 < 2; ++nt2) { u32x2 w; w.x = pk2(O[tt][nt2][0], O[tt][nt2][1]); w.y = pk2(O[tt][nt2][2], O[tt][nt2][3]);
                *(u32x2*)(og + (size_t)(tok0 + 16 * tt + lr) * D + vcol0 + 16 * nt2 + 4 * lq) = w; }
#pragma unroll
        for (int mt = 0; mt < 16; ++mt) { const f32x4 dv = *(const LAS f32x4*)(dl + 16 * mt + 4 * lq); S[mt][0] = S[mt][0] * dv; S[mt][1] = S[mt][1] * dv;
            const bf16x8 a0 = *(const LAS bf16x8*)(ksm + (16 * mt + lr) * 72 + 8 * lq), a1 = *(const LAS bf16x8*)(ksm + (16 * mt + lr) * 72 + 32 + 8 * lq);
            S[mt][0] = __builtin_amdgcn_mfma_f32_16x16x32_bf16(a0, vt00, S[mt][0], 0, 0, 0); S[mt][0] = __builtin_amdgcn_mfma_f32_16x16x32_bf16(a1, vt01, S[mt][0], 0, 0, 0);
            S[mt][1] = __builtin_amdgcn_mfma_f32_16x16x32_bf16(a0, vt10, S[mt][1], 0, 0, 0); S[mt][1] = __builtin_amdgcn_mfma_f32_16x16x32_bf16(a1, vt11, S[mt][1], 0, 0, 0);
            if (mt & 1) asm volatile("" ::: "memory"); }
        __syncthreads();
    }
#undef GS_DMA_Q
#undef GS_LOAD_K
    if (!lat) { const int te = ltid(F.wave0), lre = te & 15, lqe = (te >> 4) & 3;
        float* so = F.out + (dir ? O_SB : O_SF) + ((size_t)((b * 2 + l) * 4 + h) * 256) * 512 + vs * 256 + 32 * F.wave + lre;
#pragma unroll
        for (int mt = 0; mt < 16; ++mt)
#pragma unroll
            for (int i = 0; i < 4; ++i) { __builtin_nontemporal_store(S[mt][0][i], so + (size_t)(16 * mt + 4 * lqe + i) * 512); __builtin_nontemporal_store(S[mt][1][i], so + (size_t)(16 * mt + 4 * lqe + i) * 512 + 16); if (i == 3) asm volatile("" ::: "memory"); } }
}

__device__ __forceinline__ void attn_item(const Frame& F, int u) {
    int rowq, rowk, seq, h, c, vh;
    if (u < 512) { vh = u & 1; c = (u >> 1) & 1; const int qb = (u >> 2) & 7; h = (u >> 5) & 7; const int b = u >> 8; rowq = RC + b * 2048 + qb * 256; rowk = RC + b * 2304; seq = 2304; }
    else { const int v = u - 512; vh = v & 1; c = (v >> 1) & 1; h = (v >> 2) & 7; const int b = v >> 5; rowq = b * 256; rowk = b * 256; seq = 256; }
    const int rowqk = (u < 512) ? rowq : rowq;
    const bf16_t* Q = WSB(WS_DQ) + (size_t)rowqk * D + h * 256 + c * 128; const bf16_t* Kp = WSB(WS_DK) + (size_t)rowk * D + h * 256 + c * 128; const bf16_t* Vp = WSB(WS_DV) + (size_t)rowk * D + h * 256 + vh * 128;
    bf16_t* O = WSB(WS_OPART) + (size_t)rowq * 4096 + h * 512 + c * 256 + vh * 128;
    attn::attn_dense_body<2048, 2048, 4096>(Q, Kp, Vp, O, seq, (char*)F.lds, F.wave0);
    __syncthreads();
}

struct SchedIn { int G, c; const char* H; const char* W;
    __device__ __forceinline__ bool next(int i, pg8::Unit& u) const { const long L = (long)i * G + c; if (L >= 4032) return false;
        if (L >= 3840) { const int q = (int)L - 3840, pm = q >> 2, kq = q & 3;
            u.a = H + (size_t)pm * 256 * 2048 * 2 + (size_t)kq * 1024; u.b = W + (size_t)72 * 256 * 2048 * 2 + (size_t)kq * 1024; u.pm = pm; u.pn = 72; u.z = 2 + kq; u.nt = 8; return true; }
        const int x = (int)(L & 7), j = (int)(L >> 3);
        if (j < 432) { const int br = j >> 5, s = j & 31; int b, pnh = 0;
            if (br < 13) b = br * 8 + x; else { b = 104 + (x >> 1); pnh = 4 * (x & 1); }
            const int pm = 4 * (b % 12) + (s & 3), pn = 8 * (b / 12) + pnh + (s >> 2);
            u.a = H + (size_t)pm * 256 * 2048 * 2; u.b = W + (size_t)pn * 256 * 2048 * 2; u.pm = pm; u.pn = pn; u.z = 0; }
        else { const int jz = j - 432; int zb, s, pnh = 0;
            if (jz < 16) { zb = 8 + (x >> 1); s = jz; pnh = 4 * (x & 1); } else { zb = x; s = jz - 16; }
            const int pm = 4 * (zb & 1) + (s & 3), pn = 8 * (zb >> 1) + pnh + (s >> 2);
            u.a = W + (size_t)(NIN_MAIN + pm * 256) * 2048 * 2; u.b = H + (size_t)pn * 256 * 2048 * 2; u.pm = pm; u.pn = pn; u.z = 1; }
        return true; } };
struct SchedZa { int c; const char* H; const char* W;
    __device__ __forceinline__ bool next(int i, pg8::Unit& u) const { if (i != 0 || c >= 192) return false; const int pm = c >> 2, kq = c & 3;
        u.a = H + (size_t)pm * 256 * 2048 * 2 + (size_t)kq * 1024; u.b = W + (size_t)72 * 256 * 2048 * 2 + (size_t)kq * 1024; u.pm = pm; u.pn = 72; u.z = kq; return true; } };
struct SchedOne { pg8::Unit u0;
    __device__ __forceinline__ bool next(int i, pg8::Unit& u) const { if (i != 0) return false; u = u0; return true; } };
struct SchedBr { int G, c; const char* ws; int mode;
    __device__ __forceinline__ bool next(int i, pg8::Unit& u) const {
        int z, pm, pn; size_t koff = 0;
        const long L = (long)i * G + c; if (L >= 1280) return false;
        if (L < 768) { z = (int)L / 384; pg8::tile_order((int)L % 384, 48, 8, pm, pn); } else if (L < 1024) { z = 2; pg8::tile_order((int)L - 768, 32, 8, pm, pn); }
        else { const int cc = (int)L - 1024, kh = cc & 1, t = cc >> 1; pm = 32 + (t >> 3); pn = t & 7; z = 2 | (kh << 2); koff = (size_t)kh * 1024 * 2; u.nt = 16; }
        const int zb = z & 3; const size_t aoff = (zb == 0) ? WS_AGLA : ((zb == 1) ? WS_OFNET : WS_ADIFF);
        u.a = ws + aoff + (size_t)pm * 256 * 2048 * 2 + koff; u.b = ws + WS_WBR + (size_t)(zb * 2048 + pn * 256) * 2048 * 2 + koff; u.pm = pm; u.pn = pn; u.z = z; return true; } };
struct SchedOut { int G, c; const char* A; const char* B;
    __device__ __forceinline__ bool next(int i, pg8::Unit& u) const { const long L = (long)i * G + c; if (L >= 512) return false;
        if (L < 256) { int pm, pn; pg8::tile_order((int)L, 32, 8, pm, pn); u.a = A + (size_t)pm * 256 * 2048 * 2; u.b = B + (size_t)pn * 256 * 2048 * 2; u.pm = pm; u.pn = pn; u.z = 0; return true; }
        const int cc = (int)L - 256, kh = cc & 1, t = cc >> 1, pm = 32 + (t >> 3), pn = t & 7;
        u.a = A + (size_t)pm * 256 * 2048 * 2 + (size_t)kh * 2048; u.b = B + (size_t)pn * 256 * 2048 * 2 + (size_t)kh * 2048; u.pm = pm; u.pn = pn; u.z = kh; u.nt = 16; return true; } };
struct SchedOutHalf { int c; const char* A; const char* B;
    __device__ __forceinline__ bool next(int i, pg8::Unit& u) const { if (i != 0 || c >= 256) return false; const int kh = c & 1, t = c >> 1, pm = 32 + (t >> 3), pn = t & 7;
        u.a = A + (size_t)pm * 256 * 2048 * 2 + (size_t)kh * 2048; u.b = B + (size_t)pn * 256 * 2048 * 2 + (size_t)kh * 2048; u.pm = pm; u.pn = pn; u.z = kh; return true; } };
struct SchedPlain { int G, c, nM, nN; const char* A; const char* B; size_t sa, sb;
    __device__ __forceinline__ bool next(int i, pg8::Unit& u) const { const long L = (long)i * G + c; if (L >= (long)nM * nN) return false;
        int pm, pn; pg8::tile_order((int)L, nM, nN, pm, pn); u.a = A + (size_t)pm * sa; u.b = B + (size_t)pn * sb; u.pm = pm; u.pn = pn; u.z = 0; return true; } };
struct SchedUp { int G, c; const char* A; const char* B;
    __device__ __forceinline__ bool next(int i, pg8::Unit& u) const { const long L = (long)i * G + c; if (L >= 2304) return false;
        if (L >= 2048) { const int q = (int)L - 2048, t = q >> 2, kq = q & 3, pm = t < 44 ? 0 : 1, pn = t < 44 ? t : t - 44;
            u.a = A + (size_t)pm * 256 * 2048 * 2 + (size_t)kq * 1024; u.b = B + (size_t)pn * 256 * 2048 * 2 + (size_t)kq * 1024; u.pm = kq * 64 + t; u.pn = 0; u.z = 1; u.nt = 8; return true; }
        int pm, pn; if (L < 2024) { pg8::tile_order((int)L, 46, 44, pm, pn); pm += 2; } else { pm = 1; pn = 20 + ((int)L - 2024); }
        u.a = A + (size_t)pm * 256 * 2048 * 2; u.b = B + (size_t)pn * 256 * 2048 * 2; u.pm = pm; u.pn = pn; u.z = 0; return true; } };
struct SchedUpQ { int c; const char* A; const char* B;
    __device__ __forceinline__ bool next(int i, pg8::Unit& u) const { if (i != 0 || c >= 256) return false; const int t = c >> 2, kq = c & 3, pm = t < 44 ? 0 : 1, pn = t < 44 ? t : t - 44;
        u.a = A + (size_t)pm * 256 * 2048 * 2 + (size_t)kq * 1024; u.b = B + (size_t)pn * 256 * 2048 * 2 + (size_t)kq * 1024; u.pm = kq * 64 + t; u.pn = 0; u.z = 0; return true; } };
struct SchedDown { int G, c; const char* A; const char* B;
    __device__ __forceinline__ bool next(int i, pg8::Unit& u) const { const long L = (long)i * G + c; if (L >= 512) return false;
        if (L < 256) { int pm, pn; pg8::tile_order((int)L, 32, 8, pm, pn); u.a = A + (size_t)pm * 256 * DFF * 2; u.b = B + (size_t)pn * 256 * DFF * 2; u.pm = pm; u.pn = pn; u.z = 0; return true; }
        const int cc = (int)L - 256, z = cc & 1, t = cc >> 1, pm = 32 + (t >> 3), pn = t & 7;
        u.a = A + ((size_t)pm * 256 * DFF + (size_t)z * (DFF / 2)) * 2; u.b = B + ((size_t)pn * 256 * DFF + (size_t)z * (DFF / 2)) * 2; u.pm = pm; u.pn = pn; u.z = z; u.nt = 44; return true; } };
struct SchedF1 { int G, c; const char* T; const char* ZF;
    __device__ __forceinline__ bool next(int i, pg8::Unit& u) const { const long L = (long)i * G + c; if (L >= 768) return false;
        const int z = (int)L / 192, r = (int)L % 192, pm = r & 3, pn = r >> 2;
        u.a = T + (size_t)pm * 256 * 512 * 2; u.b = ZF + ((size_t)z * R + (size_t)pn * 256) * 512 * 2; u.pm = pm; u.pn = pn; u.z = z; return true; } };
struct SchedF2c { int G, c; const char* T; const char* Y;
    __device__ __forceinline__ bool next(int i, pg8::Unit& u) const { const long L = (long)i * G + c; if (L >= 256) return false;
        const int b = (int)L >> 3, pn = (int)L & 7; u.a = T; u.b = Y + ((size_t)pn * 256 * 24576 + (size_t)b * 512) * 2; u.pm = b; u.pn = pn; u.z = 0; return true; } };
struct SchedF2l { int G, c; const char* T; const char* Y;
    __device__ __forceinline__ bool next(int i, pg8::Unit& u) const { const long L = (long)i * G + c; if (L >= 64) return false;
        const int b = (int)L >> 5, p8 = ((int)L >> 3) & 3, pn = (int)L & 7;
        u.a = T + (size_t)p8 * 256 * 4096 * 2; u.b = Y + ((size_t)pn * 256 * 24576 + 16384 + (size_t)b * 4096) * 2; u.pm = 32 + b * 8 + p8; u.pn = pn; u.z = 0; return true; } };

__global__ void __launch_bounds__(512, 2) mega(Args args) {
    extern __shared__ __attribute__((aligned(16))) unsigned char lds_raw[];
    Frame F; F.in = args.in; F.out = args.out; F.ws = args.ws; F.lds = (LAS unsigned char*)lds_raw;
    F.wave0 = __builtin_amdgcn_readfirstlane((int)threadIdx.x >> 6); F.tid = ltid(F.wave0); F.lane = F.tid & 63; F.wave = F.wave0; F.G = gridDim.x; F.bid = blockIdx.x;
    unsigned* ctl = (unsigned*)(F.ws + WS_CTL);
    for (int u = F.tid; u < (LDS_BYTES - LDS_MISC) / 4; u += 512) ((LAS unsigned*)(F.lds + LDS_MISC))[u] = 0u;
    __syncthreads();
    const int lo = args.ph_lo, hi = args.ph_hi;
    XcdBarrier bar; bar.bar = ctl + CW_BAR; bar.x = 0; bar.st = nullptr;
    if (hi - lo > 1) bar = xcd_barrier_post(ctl + CW_BAR, (volatile LAS unsigned*)(F.lds + LDS_MISC + 32));
#ifndef PH_MASK
#define PH_MASK 0x3fff
#endif
#define RELAUNDER() do { F.tid = ltid(F.wave0); F.lane = F.tid & 63; F.wave = F.wave0; { int b_ = (int)blockIdx.x; asm volatile("" : "+s"(b_)); F.bid = b_; } { GAS unsigned char* w_ = (GAS unsigned char*)args.ws; asm volatile("" : "+s"(w_)); F.ws = (unsigned char*)w_; } { GAS float* o_ = (GAS float*)args.out; asm volatile("" : "+s"(o_)); F.out = (float*)o_; } } while (0)
#ifndef PROBE_REP
#define PROBE_REP 0
#endif
#define REPS(j) ((((PROBE_REP) >> (j)) & 1) ? 2 : 1)
#define IN(k) (lo <= (k) && (k) < hi)
#define INJ(j) ((((PH_MASK) >> ((j) + 1)) & 1) && IN(pb + (j)))
#define SEAM(k) do { if (IN(k) && IN((k) + 1)) xcd_barrier(bar); } while (0)
    if ((PH_MASK & 1) && IN(0)) { RELAUNDER(); ph_prologue(F); } SEAM(0);
    for (int l = 0; l < 2; ++l) {
        const int pb = 1 + 13 * l;
        if (l == 0) { if (INJ(0)) { RELAUNDER(); ph_weights(F, 0); RELAUNDER(); ph_norm1(F, 0); ph_cache(F, 0); } SEAM(pb + 0); }
        if (INJ(1)) { for (int rep_ = 0; rep_ < REPS(1); ++rep_) { RELAUNDER();
            pg8::Gemm g{2048, 2048, 2048}; SchedIn S{F.G, F.bid, (const char*)F.ws + WS_H, (const char*)F.ws + WS_WIN};
            pg8::EpiIn E{F.ws, F.out, l};
            pg8::gemm_phase<pg8::EpiIn, SchedIn, true, true>(F.lds, g, S, E, F.wave0);
            }
        } SEAM(pb + 1);
        if (INJ(2)) { RELAUNDER();
#ifndef SUB
#define SUB 0xff
#endif
            if (SUB & 1) for (int rep_ = 0; rep_ < REPS(2); ++rep_) for (int it = F.bid; it < 768; it += F.G) gla_pre_item(F, l, it);
            RELAUNDER();
            if (SUB & 2) ph_rope(F);
            RELAUNDER();
            if (SUB & 4) for (int rep_ = 0; rep_ < REPS(2); ++rep_) { RELAUNDER();
            pg8::Gemm g{512, 512, 512}; SchedF1 S{F.G, F.bid, (const char*)F.ws + WS_T512, (const char*)F.ws + WS_ZF}; pg8::EpiY E{WSB(WS_Y)};
            pg8::gemm_phase<pg8::EpiY, SchedF1, true, true>(F.lds, g, S, E, F.wave0); }
        } SEAM(pb + 2);
        if (INJ(3)) { RELAUNDER();
            { pg8::Gemm g{4096, 24576, 4096}; SchedF2l S{F.G, F.bid, (const char*)F.ws + WS_T2048, (const char*)F.ws + WS_Y}; pg8::EpiBf16 E{WSB(WS_OFNET), 2048};
              pg8::gemm_phase<pg8::EpiBf16, SchedF2l, true, true>(F.lds, g, S, E, F.wave0); }
            RELAUNDER();
            {   LAS int* qslot = (LAS int*)(F.lds + LDS_MISC + 64);
                for (;;) {
                    if (F.tid == 0) *qslot = (int)__hip_atomic_fetch_add(ctl + CW_Q + 64 * l, 1u, __ATOMIC_RELAXED, __HIP_MEMORY_SCOPE_AGENT);
                    __syncthreads(); const int id = *qslot; __syncthreads();
                    if (id >= 2080) break;
                    if (id < 32 || (id >= 544 && id < 1056)) gla_scan_item(F, l, id < 32 ? id : id - 544 + 32);
                    else attn_item(F, id < 544 ? id - 32 : id - 1056 + 512);
                }
            }
            RELAUNDER();
            { pg8::Gemm g{512, 24576, 512}; SchedF2c S{F.G, F.bid, (const char*)F.ws + WS_T256, (const char*)F.ws + WS_Y}; pg8::EpiBf16 E{WSB(WS_OFNET), 2048};
              pg8::gemm_phase<pg8::EpiBf16, SchedF2c, true, true>(F.lds, g, S, E, F.wave0); }
        } SEAM(pb + 3);
        if (INJ(4)) { for (int rep_ = 0; rep_ < REPS(4); ++rep_) { RELAUNDER(); ph_postmix(F, l); } } SEAM(pb + 4);
        if (INJ(5)) { for (int rep_ = 0; rep_ < REPS(5); ++rep_) { RELAUNDER();
            { pg8::Gemm g{2048, 2048, 2048}; SchedBr S{F.G, F.bid, (const char*)F.ws, 0}; pg8::EpiBr E{F.ws + WS_P, WSB(WS_GATE)};
              pg8::gemm_phase<pg8::EpiBr, SchedBr, true, true>(F.lds, g, S, E, F.wave0); } }
        } SEAM(pb + 5);
        if (INJ(6)) { for (int rep_ = 0; rep_ < REPS(6); ++rep_) { RELAUNDER(); ph_merge(F); } } SEAM(pb + 6);
        if (INJ(7)) { for (int rep_ = 0; rep_ < REPS(7); ++rep_) { RELAUNDER();
            { pg8::Gemm g{2048, 2048, 2048}; SchedOut S{F.G, F.bid, (const char*)F.ws + WS_MERGED, (const char*)F.ws + WS_WOUT}; pg8::EpiBf16 E{WSB(WS_YOUT), 2048, WSB(WS_KENDT), RC};
              pg8::gemm_phase<pg8::EpiBf16, SchedOut, true, true>(F.lds, g, S, E, F.wave0); } }
        } SEAM(pb + 7);
        if (INJ(8)) { RELAUNDER(); if (l == 0) ph_mid<false>(F, 0); else ph_mid<true>(F, 1); } SEAM(pb + 8);
        if (INJ(9)) { for (int rep_ = 0; rep_ < REPS(9); ++rep_) { RELAUNDER();
            pg8::Gemm g{2048, 2048, 2048}; SchedUp S{F.G, F.bid, (const char*)F.ws + WS_H, (const char*)F.ws + WS_WUP}; pg8::EpiFfn E{WSB(WS_ACT), WSB(WS_SG), WSB(WS_SV), F.in[IN_CONVW] + (size_t)l * 3 * DFF, F.in[IN_CONVB] + (size_t)l * DFF, WSB(WS_UPQ)};
            pg8::gemm_phase<pg8::EpiFfn, SchedUp, true, true>(F.lds, g, S, E, F.wave0);
            }
        } SEAM(pb + 9);
        if (INJ(10)) { for (int rep_ = 0; rep_ < REPS(10); ++rep_) { RELAUNDER(); ph_conv(F, l); } } SEAM(pb + 10);
        if (INJ(11)) { for (int rep_ = 0; rep_ < REPS(11); ++rep_) { RELAUNDER();
            pg8::Gemm g{DFF, DFF, DFF}; SchedDown S{F.G, F.bid, (const char*)F.ws + WS_ACT, (const char*)F.ws + WS_WDOWN}; pg8::EpiBf16z E{F.ws};
            pg8::gemm_phase<pg8::EpiBf16z, SchedDown, true, true>(F.lds, g, S, E, F.wave0); }
        } SEAM(pb + 11);
        if (INJ(12)) { RELAUNDER();
            if (l == 0) { ph_weights(F, 1); RELAUNDER(); ph_final<true>(F, 0); ph_cache(F, 1); } else ph_final<false>(F, 1); }
        if (l == 0) { if (IN(pb + 12) && IN(pb + 14)) xcd_barrier(bar); }
    }
#undef IN
#undef SEAM
}

extern "C" void kernel_launch(void* const* d_in, const int* in_sizes, int n_in, void* d_out, int out_size, void* d_ws, size_t ws_size, hipStream_t stream) {
    static int grid = 0;
    if (grid == 0) {
        if (n_in != 33 || (size_t)out_size != O_END || ws_size < WS_END) { fprintf(stderr, "kernel_launch: unexpected shapes (n_in %d out %d ws %zu)\n", n_in, out_size, ws_size); grid = -1; return; }
        int dev = 0, cus = 0, per_cu = 0;
        if (hipGetDevice(&dev) != hipSuccess || hipDeviceGetAttribute(&cus, hipDeviceAttributeMultiprocessorCount, dev) != hipSuccess) { grid = -1; return; }
        if (hipFuncSetAttribute((const void*)mega, hipFuncAttributeMaxDynamicSharedMemorySize, LDS_BYTES) != hipSuccess) { fprintf(stderr, "kernel_launch: hipFuncSetAttribute failed\n"); grid = -1; return; }
        if (hipOccupancyMaxActiveBlocksPerMultiprocessor(&per_cu, (const void*)mega, 512, LDS_BYTES) != hipSuccess || per_cu < 1) { fprintf(stderr, "kernel_launch: occupancy query says %d\n", per_cu); }
        (void)hipGetLastError();
        grid = cus;
    }
    if (grid < 0) return;
    (void)hipMemsetAsync((char*)d_ws + WS_CTL, 0, CTL_BYTES, stream);
    Args a{};
    for (int i = 0; i < 33; ++i) a.in[i] = (const float*)d_in[i];
    a.out = (float*)d_out; a.ws = (unsigned char*)d_ws;
#if MK_MODE == 0
    a.ph_lo = 0; a.ph_hi = NPH;
    hipLaunchKernelGGL(mega, dim3(grid), dim3(512), LDS_BYTES, stream, a);
#else
    for (int p = 0; p < NPH; ++p) { a.ph_lo = p; a.ph_hi = p + 1; hipLaunchKernelGGL(mega, dim3(grid), dim3(512), LDS_BYTES, stream, a); }
#endif
}
```
